# Optimizing an MI355X kernel written in HIP

```python
import jax
import jax.numpy as jnp
from jax import lax
import numpy as np

D_MODEL = 1024
BATCH = 8
SEQ = 4096
DEPTH = 2

GRID_W = 64
CTX_LEN = 256
INNER = 2 * D_MODEL
NA_HEADS = 16
NA_DIM = D_MODEL // NA_HEADS
NA_WIDTH = NA_HEADS * NA_DIM
NA_WIN_H = 8
NA_WIN_W = 16
ML_HEADS = 4
ML_DIM = D_MODEL // ML_HEADS
ML_WIDTH = ML_HEADS * ML_DIM
ML_CHUNK = 64
HG_HEADS = 16
HG_KDIM = 128
HG_VDIM = INNER // HG_HEADS
HG_KW = HG_HEADS * HG_KDIM
HG_VW = HG_HEADS * HG_VDIM
HG_CHUNK = 32
ROPE_BASE = 10000.0
EPS = 1e-6
N_AB = (DEPTH + 1) // 2
N_C = DEPTH // 2
AB_SIZES = (NA_WIDTH,) * 4 + (ML_WIDTH,) * 5 + (4 * ML_HEADS,)
C_SIZES = (HG_KW, HG_KW, HG_KW, HG_VW, HG_VW)
AB_IN = sum(AB_SIZES)
C_IN = sum(C_SIZES)
F32 = jnp.float32

kernel_name = "hybrid_na_mlstm_hgrn2_dit"


def _rms(x, w):
    xf = x.astype(F32)
    y = xf * lax.rsqrt(jnp.mean(xf * xf, axis=-1, keepdims=True) + EPS)
    return (y * w.astype(F32)).astype(x.dtype)


def _heads(t, n):
    return t.reshape(t.shape[:-1] + (n, t.shape[-1] // n))


def _bht(a):
    return jnp.swapaxes(a, 1, 2).astype(F32)


def _split_cols(p, sizes):
    return jnp.split(p, [int(s) for s in np.cumsum(sizes)[:-1]], axis=-1)


def _same(a):
    return a


def _flip_t(a):
    return jnp.flip(a, axis=2)


def _ada(cvec, w, b):
    m = jax.nn.silu(cvec) @ w + b
    return jnp.split(m.reshape((-1, 1, m.shape[-1])), 3, axis=-1)


def _rope_1d(x, pos):
    half = x.shape[-1] // 2
    freqs = ROPE_BASE ** (-jnp.arange(half, dtype=F32) / half)
    ang = pos.astype(F32)[:, None] * freqs[None, :]
    cos, sin = jnp.cos(ang)[:, None, :], jnp.sin(ang)[:, None, :]
    x1, x2 = x[..., :half], x[..., half:]
    return jnp.concatenate([x1 * cos - x2 * sin, x2 * cos + x1 * sin], axis=-1)


def _axial_rope(x):
    t = jnp.arange(x.shape[1])
    half = x.shape[-1] // 2
    xf = x.astype(F32)
    out = jnp.concatenate([_rope_1d(xf[..., :half], t // GRID_W),
                           _rope_1d(xf[..., half:], t % GRID_W)], axis=-1)
    return out.astype(x.dtype)


def _to_chunks(a, L):
    B, H, T = a.shape[:3]
    return jnp.moveaxis(a.reshape((B, H, T // L, L) + a.shape[3:]), 2, 0)


def _from_chunks(a):
    a = jnp.moveaxis(a, 0, 2)
    return a.reshape(a.shape[:2] + (-1,) + a.shape[4:])


def _mlstm_chunkwise(q, k, v, ig, fg, state):
    L = ML_CHUNK
    lf = jax.nn.log_sigmoid(fg)
    tri = jnp.tril(jnp.ones((L, L), bool))

    def step(carry, xs):
        C, n, m = carry
        qc, kc, vc, ic, lfc = xs
        b = jnp.cumsum(lfc, axis=-1)
        dmat = jnp.where(tri, b[..., :, None] - b[..., None, :] + ic[..., None, :], -jnp.inf)
        m_inter = b + m[..., None]
        m_t = jnp.maximum(jnp.max(dmat, axis=-1), m_inter)
        s = jnp.einsum('bhtk,bhsk->bhts', qc, kc) * jnp.exp(dmat - m_t[..., None])
        carry_w = jnp.exp(m_inter - m_t)
        num = jnp.einsum('bhts,bhsv->bhtv', s, vc) + carry_w[..., None] * jnp.einsum('bhtk,bhkv->bhtv', qc, C)
        den = jnp.sum(s, axis=-1) + carry_w * jnp.einsum('bhtk,bhk->bht', qc, n)
        h = num / jnp.maximum(jnp.abs(den), jnp.exp(-m_t))[..., None]
        bL = b[..., -1]
        g = bL[..., None] - b + ic
        m_new = jnp.maximum(bL + m, jnp.max(g, axis=-1))
        kw = kc * jnp.exp(g - m_new[..., None])[..., None]
        dec = jnp.exp(bL + m - m_new)
        C = dec[..., None, None] * C + jnp.einsum('bhsk,bhsv->bhkv', kw, vc)
        n = dec[..., None] * n + jnp.sum(kw, axis=2)
        return (C, n, m_new), h

    xs = tuple(_to_chunks(a, L) for a in (q, k, v, ig, lf))
    state, h = lax.scan(step, state, xs)
    return _from_chunks(h), state


def _mlstm_final_state(k, v, ig, fg):
    b = jnp.cumsum(jax.nn.log_sigmoid(fg), axis=-1)
    g = b[..., -1:] - b + ig
    m = jnp.max(g, axis=-1)
    kw = k * jnp.exp(g - m[..., None])[..., None]
    return (jnp.einsum('bhsk,bhsv->bhkv', kw, v), jnp.sum(kw, axis=2), m)


def _mlstm_bidir(lat, ctx, need_ctx):
    q_l, k_l, v_l, g_l = lat
    q_c, k_c, v_c, g_c = ctx
    B, H, _, dk = q_l.shape
    dv = v_l.shape[-1]
    out_l, out_c = [], []
    for d, tr in enumerate((_same, _flip_t)):
        ic, fc = tr(g_c[..., 2 * d]), tr(g_c[..., 2 * d + 1])
        il, fl = tr(g_l[..., 2 * d]), tr(g_l[..., 2 * d + 1])
        if need_ctx:
            zero = (jnp.zeros((B, H, dk, dv), F32), jnp.zeros((B, H, dk), F32), jnp.zeros((B, H), F32))
            h_c, st = _mlstm_chunkwise(tr(q_c), tr(k_c), tr(v_c), ic, fc, zero)
            out_c.append(tr(h_c))
        else:
            st = _mlstm_final_state(tr(k_c), tr(v_c), ic, fc)
        h_l, _ = _mlstm_chunkwise(tr(q_l), tr(k_l), tr(v_l), il, fl, st)
        out_l.append(tr(h_l))
    return out_l[0] + out_l[1], (out_c[0] + out_c[1] if need_ctx else None)


def _gla_chunkwise(q, k, v, lf, S):
    L = HG_CHUNK
    tri = jnp.tril(jnp.ones((L, L), bool))[..., None]

    def step(S, xs):
        qc, kc, vc, lfc = xs
        b = jnp.cumsum(lfc, axis=2)
        o = jnp.einsum('bhtk,bhkv->bhtv', qc * jnp.exp(b), S)
        pair = jnp.exp(jnp.where(tri, b[:, :, :, None, :] - b[:, :, None, :, :], -jnp.inf))
        a = jnp.einsum('bhtk,bhtsk->bhts', qc, pair * kc[:, :, None, :, :])
        o = o + jnp.einsum('bhts,bhsv->bhtv', a, vc)
        bL = b[:, :, -1:, :]
        S = jnp.exp(bL[:, :, 0])[..., None] * S + jnp.einsum('bhsk,bhsv->bhkv', kc * jnp.exp(bL - b), vc)
        return S, o

    xs = tuple(_to_chunks(a, L) for a in (q, k, v, lf))
    S, o = lax.scan(step, S, xs)
    return _from_chunks(o), S


def _gla_final_state(k, v, lf):
    b = jnp.cumsum(lf, axis=2)
    return jnp.einsum('bhsk,bhsv->bhkv', k * jnp.exp(b[:, :, -1:] - b), v)


def _gla_bidir(lat, ctx, need_ctx):
    q_l, v_l, dirs_l = lat
    q_c, v_c, dirs_c = ctx
    B, H, _, dk = q_l.shape
    dv = v_l.shape[-1]
    out_l, out_c = [], []
    for d, tr in enumerate((_same, _flip_t)):
        (k_l, lf_l), (k_c, lf_c) = dirs_l[d], dirs_c[d]
        if need_ctx:
            o_c, S = _gla_chunkwise(tr(q_c), tr(k_c), tr(v_c), tr(lf_c), jnp.zeros((B, H, dk, dv), F32))
            out_c.append(tr(o_c))
        else:
            S = _gla_final_state(tr(k_c), tr(v_c), tr(lf_c))
        o_l, _ = _gla_chunkwise(tr(q_l), tr(k_l), tr(v_l), tr(lf_l), S)
        out_l.append(tr(o_l))
    return out_l[0] + out_l[1], (out_c[0] + out_c[1] if need_ctx else None)


def _neighbourhood_attention(q, k, v, k_ctx, v_ctx, rpb):
    B, T, H, d = q.shape
    rows = T // GRID_W
    kh, kw = min(NA_WIN_H, rows), NA_WIN_W
    qg = (q * (d ** -0.5)).reshape(B, rows, GRID_W, H, d)
    kg = k.reshape(B, rows, GRID_W, H, d)
    vg = v.reshape(B, rows, GRID_W, H, d)
    col = jnp.arange(GRID_W)
    col_idx = jnp.clip(col - kw // 2, 0, GRID_W - kw)[:, None] + jnp.arange(kw)[None, :]
    col_bias = rpb[:, :, col_idx - col[:, None] + NA_WIN_W - 1]

    def one_row(r):
        r0 = jnp.clip(r - kh // 2, 0, rows - kh)
        q_r = lax.dynamic_index_in_dim(qg, r, axis=1, keepdims=False)
        k_nb = lax.dynamic_slice_in_dim(kg, r0, kh, axis=1)[:, :, col_idx]
        v_nb = lax.dynamic_slice_in_dim(vg, r0, kh, axis=1)[:, :, col_idx]
        row_off = r0 + jnp.arange(kh) - r + NA_WIN_H - 1
        bias = jnp.transpose(jnp.take(col_bias, row_off, axis=1), (0, 2, 1, 3))
        s_nb = jnp.einsum('bqhd,baqwhd->bhqaw', q_r, k_nb).astype(F32) + bias[None].astype(F32)
        s_cx = jnp.einsum('bqhd,bchd->bhqc', q_r, k_ctx).astype(F32)
        p = jax.nn.softmax(jnp.concatenate([s_nb.reshape(B, H, GRID_W, kh * kw), s_cx], axis=-1), axis=-1)
        p = p.astype(v.dtype)
        p_nb = p[..., :kh * kw].reshape(B, H, GRID_W, kh, kw)
        return (jnp.einsum('bhqaw,baqwhd->bqhd', p_nb, v_nb)
                + jnp.einsum('bhqc,bchd->bqhd', p[..., kh * kw:], v_ctx))

    out = lax.map(one_row, jnp.arange(rows))
    return jnp.moveaxis(out, 0, 1).reshape(B, T, H, d)


def _context_attention(q, k, v):
    s = jnp.einsum('bqhd,bkhd->bhqk', q, k).astype(F32) * (q.shape[-1] ** -0.5)
    p = jax.nn.softmax(s, axis=-1).astype(v.dtype)
    return jnp.einsum('bhqk,bkhd->bqhd', p, v)


def _ab_mixer(h_lat, h_ctx, w_in, b_gate, q_norm, k_norm, rpb, h_norm, w_out, need_ctx):
    def project(h, rotary):
        qa, ka, va, za, qb, kb, vb, ob, zb, g = _split_cols(h @ w_in, AB_SIZES)
        qa = _rms(_heads(qa, NA_HEADS), q_norm)
        ka = _rms(_heads(ka, NA_HEADS), k_norm)
        qb, kb = _heads(qb, ML_HEADS), _heads(kb, ML_HEADS) * (ML_DIM ** -0.5)
        if rotary:
            qb, kb = _axial_rope(qb), _axial_rope(kb)
        gates = jnp.transpose(_heads(g + b_gate, 4), (0, 3, 1, 2)).astype(F32)
        mb = (_bht(qb), _bht(kb), _bht(_heads(vb, ML_HEADS)), gates)
        return (qa, ka, _heads(va, NA_HEADS), za), mb, (ob, zb)

    (qa_l, ka_l, va_l, za_l), mb_l, (ob_l, zb_l) = project(h_lat, True)
    (qa_c, ka_c, va_c, za_c), mb_c, (ob_c, zb_c) = project(h_ctx, False)
    oa_l = _neighbourhood_attention(qa_l, ka_l, va_l, ka_c, va_c, rpb)
    hb_l, hb_c = _mlstm_bidir(mb_l, mb_c, need_ctx)

    def merge(oa, hb, za, ob, zb):
        hb = jnp.swapaxes(hb, 1, 2).astype(ob.dtype) * jax.nn.sigmoid(_heads(ob, ML_HEADS))
        hb = _rms(hb, h_norm.reshape(ML_HEADS, ML_DIM))
        ya = oa.reshape(oa.shape[:2] + (NA_WIDTH,)) * jax.nn.silu(za)
        yb = hb.reshape(hb.shape[:2] + (ML_WIDTH,)) * jax.nn.silu(zb)
        return jnp.concatenate([ya, yb], axis=-1) @ w_out

    y_lat = merge(oa_l, hb_l, za_l, ob_l, zb_l)
    y_ctx = merge(_context_attention(qa_c, ka_c, va_c), hb_c, za_c, ob_c, zb_c) if need_ctx else None
    return y_lat, y_ctx


def _c_mixer(h_lat, h_ctx, w_in, lb, h_norm, w_out, need_ctx):
    def project(h):
        q, f_fwd, f_bwd, i, z = _split_cols(h @ w_in, C_SIZES)

        def decay(f_pre):
            f = lb + (1.0 - lb) * jax.nn.sigmoid(f_pre.astype(F32))
            return _bht(_heads(1.0 - f, HG_HEADS)), _bht(_heads(jnp.log(f), HG_HEADS))

        rec = (_bht(_heads(jax.nn.silu(q), HG_HEADS)), _bht(_heads(i, HG_HEADS)), (decay(f_fwd), decay(f_bwd)))
        return rec, z

    rec_l, z_l = project(h_lat)
    rec_c, z_c = project(h_ctx)
    o_l, o_c = _gla_bidir(rec_l, rec_c, need_ctx)

    def merge(o, z):
        o = _rms(jnp.swapaxes(o, 1, 2).astype(z.dtype), h_norm.reshape(HG_HEADS, HG_VDIM))
        return (o.reshape(o.shape[:2] + (HG_VW,)) * jax.nn.silu(z)) @ w_out

    return merge(o_l, z_l), (merge(o_c, z_c) if need_ctx else None)


def _lower_bound(lb_param, layer):
    s = jax.nn.softmax(lb_param.astype(F32), axis=0)
    return (jnp.cumsum(s, axis=0) - s[0])[layer]


def setup_inputs(seed: int = 0) -> dict:
    key = jax.random.key(seed)
    ks = jax.random.split(key, 22)

    def nrm(k, shape, s):
        return jax.random.normal(k, shape, F32) * s

    f_bias = jnp.linspace(3.0, 6.0, ML_HEADS, dtype=F32)
    b_gate_ab = jnp.concatenate([nrm(ks[8], (N_AB, ML_HEADS), 0.1),
                                 f_bias + nrm(ks[9], (N_AB, ML_HEADS), 0.1),
                                 nrm(ks[10], (N_AB, ML_HEADS), 0.1),
                                 f_bias + nrm(ks[11], (N_AB, ML_HEADS), 0.1)], axis=-1)
    return {
        "x": nrm(ks[0], (BATCH, SEQ, D_MODEL), 1.0),
        "c": nrm(ks[1], (BATCH, D_MODEL), 1.0),
        "ctx": nrm(ks[2], (BATCH, CTX_LEN, D_MODEL), 1.0),
        "c_ctx": nrm(ks[3], (D_MODEL,), 1.0),
        "norm_w": 1.0 + nrm(ks[4], (DEPTH, D_MODEL), 0.05),
        "w_ada": nrm(ks[5], (DEPTH, D_MODEL, 3 * D_MODEL), 0.5 * D_MODEL ** -0.5),
        "b_ada": nrm(ks[6], (DEPTH, 3 * D_MODEL), 0.02),
        "w_in_ab": nrm(ks[7], (N_AB, D_MODEL, AB_IN), D_MODEL ** -0.5),
        "b_gate_ab": b_gate_ab,
        "q_norm_a": 1.0 + nrm(ks[12], (N_AB, NA_DIM), 0.05),
        "k_norm_a": 1.0 + nrm(ks[13], (N_AB, NA_DIM), 0.05),
        "rpb_a": nrm(ks[14], (N_AB, NA_HEADS, 2 * NA_WIN_H - 1, 2 * NA_WIN_W - 1), 0.1),
        "h_norm_b": 1.0 + nrm(ks[15], (N_AB, ML_WIDTH), 0.05),
        "w_out_ab": nrm(ks[16], (N_AB, INNER, D_MODEL), INNER ** -0.5),
        "w_in_c": nrm(ks[17], (N_C, D_MODEL, C_IN), D_MODEL ** -0.5),
        "lb_c": nrm(ks[18], (DEPTH, HG_KW), 0.5),
        "h_norm_c": 1.0 + nrm(ks[19], (N_C, HG_VW), 0.05),
        "w_out_c": nrm(ks[20], (N_C, INNER, D_MODEL), INNER ** -0.5),
    }


def reference(x, c, ctx, c_ctx, norm_w, w_ada, b_ada, w_in_ab, b_gate_ab, q_norm_a, k_norm_a, rpb_a,
              h_norm_b, w_out_ab, w_in_c, lb_c, h_norm_c, w_out_c):
    for l in range(DEPTH):
        need_ctx = l < DEPTH - 1
        shift, scale, gate = _ada(c, w_ada[l], b_ada[l])
        shift_c, scale_c, gate_c = _ada(c_ctx, w_ada[l], b_ada[l])
        h_lat = _rms(x, norm_w[l]) * (1.0 + scale) + shift
        h_ctx = _rms(ctx, norm_w[l]) * (1.0 + scale_c) + shift_c
        j = l // 2
        if l % 2 == 0:
            y_lat, y_ctx = _ab_mixer(h_lat, h_ctx, w_in_ab[j], b_gate_ab[j], q_norm_a[j], k_norm_a[j],
                                     rpb_a[j], h_norm_b[j], w_out_ab[j], need_ctx)
        else:
            y_lat, y_ctx = _c_mixer(h_lat, h_ctx, w_in_c[j], _lower_bound(lb_c, l), h_norm_c[j],
                                    w_out_c[j], need_ctx)
        x = x + gate * y_lat
        if need_ctx:
            ctx = ctx + gate_c * y_ctx
    return x
```

```cpp
#include <hip/hip_runtime.h>
#include <hip/hip_cooperative_groups.h>
#include <cstdio>
namespace cg = cooperative_groups;

typedef unsigned short u16;
typedef __attribute__((ext_vector_type(8))) short bf16x8;
typedef __attribute__((ext_vector_type(4))) float f32x4;
typedef __attribute__((ext_vector_type(4))) unsigned int u32x4;
typedef __attribute__((ext_vector_type(2))) unsigned int u32x2;
typedef __attribute__((ext_vector_type(2))) __bf16 bf2_t;

#define DI __device__ __forceinline__
#define MFMA16(a, b, c) __builtin_amdgcn_mfma_f32_16x16x32_bf16((a), (b), (c), 0, 0, 0)

constexpr int NT = 512;
constexpr int LDS_ST_OFF = 159744;
constexpr int LDS_BYTES = LDS_ST_OFF + 64;
constexpr int HL = 16384;
constexpr int HR = 17408;
constexpr int S0 = 9216;
constexpr int S1 = 10240;
constexpr float EPSF = 1e-6f;

constexpr size_t OFF_WT1 = 0;
constexpr size_t OFF_WT2 = OFF_WT1 + (size_t)9472 * 1024 * 2;
constexpr size_t OFF_WT3 = OFF_WT2 + (size_t)1024 * 2048 * 2;
constexpr size_t OFF_WT4 = OFF_WT3 + (size_t)10240 * 1024 * 2;
constexpr size_t OFF_ADA = OFF_WT4 + (size_t)1024 * 2048 * 2;
constexpr size_t OFF_X1C = OFF_ADA + (size_t)2 * 9 * 3072 * 4;
constexpr size_t OFF_G = OFF_X1C + (size_t)2048 * 1024 * 4;
constexpr size_t OFF_H = OFF_G + (size_t)HR * 16 * 4;
constexpr size_t OFF_HD = OFF_H + (size_t)HR * 1024 * 2;
constexpr size_t OFF_P = OFF_HD + (size_t)2 * HR * 1024 * 2;
constexpr size_t OFF_BAR = OFF_P + (size_t)HR * 10240 * 2;
constexpr size_t WS_END = OFF_BAR + 16384;

struct Params {
  const float* x; const float* c; const float* ctx; const float* c_ctx; const float* norm_w; const float* w_ada;
  const float* b_ada; const float* w_in_ab; const float* b_gate; const float* q_norm; const float* k_norm;
  const float* rpb; const float* h_norm_b; const float* w_out_ab; const float* w_in_c; const float* lb_c;
  const float* h_norm_c; const float* w_out_c;
  float* out;
  u16* wt1; u16* wt2; u16* wt3; u16* wt4;
  float* ada; float* x1c; float* G; u16* H; u16* HD; u16* P;
  unsigned* bar;
};

extern __shared__ __attribute__((aligned(16))) unsigned char smem[];

DI u16 f2bf(float f) { __bf16 h = (__bf16)f; return __builtin_bit_cast(u16, h); }
DI unsigned pack2(float a, float b) { bf2_t v; v[0] = (__bf16)a; v[1] = (__bf16)b; return __builtin_bit_cast(unsigned, v); }
DI float bf2f(u16 h) { return __uint_as_float(((unsigned)h) << 16); }
DI float lo2f(unsigned u) { return __uint_as_float(u << 16); }
DI float hi2f(unsigned u) { return __uint_as_float(u & 0xFFFF0000u); }
DI float fastlogf_(float x) { return __builtin_amdgcn_logf(x) * 0.69314718f; }
DI float rcpf_(float x) { return __builtin_amdgcn_rcpf(x); }
DI float sigmoidf_(float v) { return rcpf_(1.f + __expf(-v)); }
DI float siluf_(float v) { return v * rcpf_(1.f + __expf(-v)); }
DI f32x4 zero4() { f32x4 z = {0.f, 0.f, 0.f, 0.f}; return z; }
template <int CTRL, int ROWMASK> DI float dpp_f(float oldv, float src) {
  return __builtin_bit_cast(float, __builtin_amdgcn_update_dpp(__builtin_bit_cast(int, oldv), __builtin_bit_cast(int, src), CTRL, ROWMASK, 0xf, false));
}
DI float wave_scan_add(float v) {
  v += dpp_f<0x111, 0xf>(0.f, v);
  v += dpp_f<0x112, 0xf>(0.f, v);
  v += dpp_f<0x114, 0xf>(0.f, v);
  v += dpp_f<0x118, 0xf>(0.f, v);
  v += dpp_f<0x142, 0xa>(0.f, v);
  v += dpp_f<0x143, 0xc>(0.f, v);
  return v;
}
DI float wave_scan_max(float v) {
  v = fmaxf(v, dpp_f<0x111, 0xf>(-INFINITY, v));
  v = fmaxf(v, dpp_f<0x112, 0xf>(-INFINITY, v));
  v = fmaxf(v, dpp_f<0x114, 0xf>(-INFINITY, v));
  v = fmaxf(v, dpp_f<0x118, 0xf>(-INFINITY, v));
  v = fmaxf(v, dpp_f<0x142, 0xa>(-INFINITY, v));
  v = fmaxf(v, dpp_f<0x143, 0xc>(-INFINITY, v));
  return v;
}
DI int get_tid() { int t = threadIdx.x; asm volatile("" : "+v"(t)); return t; }
DI int get_bid() { int b = blockIdx.x; asm volatile("" : "+s"(b)); return b; }

static __device__ __forceinline__ void ada_item(const Params& p, int item) {
  const int tid = get_tid();
  float* sc = (float*)smem;
  float* red = sc + 9216;
  const int l = item / 48, col0 = (item % 48) * 64;
  for (int i = tid; i < 9216; i += NT) {
    int r = i >> 10, k = i & 1023;
    float c = (r < 8) ? p.c[r * 1024 + k] : p.c_ctx[k];
    sc[i] = siluf_(c);
  }
  __syncthreads();
  const int w = tid >> 6, lane = tid & 63;
  float acc[9];
#pragma unroll
  for (int r = 0; r < 9; ++r) acc[r] = 0.f;
  const float* W = p.w_ada + (size_t)l * 1024 * 3072 + col0 + lane;
#pragma unroll 4
  for (int k = w * 128; k < w * 128 + 128; ++k) {
    float wv = W[(size_t)k * 3072];
#pragma unroll
    for (int r = 0; r < 9; ++r) acc[r] += sc[r * 1024 + k] * wv;
  }
#pragma unroll
  for (int r = 0; r < 9; ++r) red[(w * 9 + r) * 64 + lane] = acc[r];
  __syncthreads();
  for (int i = tid; i < 576; i += NT) {
    int r = i >> 6, cl = i & 63;
    float s = p.b_ada[l * 3072 + col0 + cl];
#pragma unroll
    for (int w2 = 0; w2 < 8; ++w2) s += red[(w2 * 9 + r) * 64 + cl];
    p.ada[(l * 9 + r) * 3072 + col0 + cl] = s;
  }
  __syncthreads();
}

static __device__ __forceinline__ void transpose_tile(const float* W, u16* Wt, int K, int N, int tn, int tk, int s_lo, int s_hi, int p_lo = 0, int p_hi = 0) {
  const int tid = get_tid();
  u16* T = (u16*)smem;
  const int n0 = tn * 64, k0 = tk * 128;
#pragma unroll
  for (int i = 0; i < 4; ++i) {
    int idx = tid + NT * i;
    int kr = idx >> 4, c4 = idx & 15;
    int n = n0 + c4 * 4;
    float4 v = make_float4(0.f, 0.f, 0.f, 0.f);
    if (n >= p_lo && n < p_hi) {
      const int sb = (n & ~127) + ((n & 127) >> 1);
      const float2 a = *(const float2*)(W + (size_t)(k0 + kr) * N + sb);
      const float2 b = *(const float2*)(W + (size_t)(k0 + kr) * N + sb + 64);
      v = make_float4(a.x, b.x, a.y, b.y);
    } else if (n < N) v = *(const float4*)(W + (size_t)(k0 + kr) * N + n);
    if (n >= s_lo && n < s_hi) { v.x *= 0.0625f; v.y *= 0.0625f; v.z *= 0.0625f; v.w *= 0.0625f; }
    T[(c4 * 4 + 0) * 136 + kr] = f2bf(v.x);
    T[(c4 * 4 + 1) * 136 + kr] = f2bf(v.y);
    T[(c4 * 4 + 2) * 136 + kr] = f2bf(v.z);
    T[(c4 * 4 + 3) * 136 + kr] = f2bf(v.w);
  }
  __syncthreads();
#pragma unroll
  for (int i = 0; i < 2; ++i) {
    int idx = tid + NT * i;
    int n = idx >> 4, ck = idx & 15;
    u32x4 val = *(const u32x4*)(T + n * 136 + ck * 8);
    *(u32x4*)(Wt + (size_t)(n0 + n) * K + k0 + ck * 8) = val;
  }
  __syncthreads();
}

static __device__ __forceinline__ void prep_phase(const Params& p) {
  const int n_items = 96 + 1184 + 1280 + 256 + 256;
  for (int item = blockIdx.x; item < n_items; item += gridDim.x) {
    if (item < 96) { ada_item(p, item); continue; }
    int t = item - 96;
    if (t < 1184) { transpose_tile(p.w_in_ab, p.wt1, 1024, 9232, t >> 3, t & 7, 5120, 6144, 4096, 6144); continue; }
    t -= 1184;
    if (t < 1280) { transpose_tile(p.w_in_c, p.wt3, 1024, 10240, t >> 3, t & 7, 0, 0); continue; }
    t -= 1280;
    if (t < 256) { transpose_tile(p.w_out_ab, p.wt2, 2048, 1024, t >> 4, t & 15, 0, 0); continue; }
    t -= 256;
    transpose_tile(p.w_out_c, p.wt4, 2048, 1024, t >> 4, t & 15, 0, 0);
  }
}

static __device__ __forceinline__ void rmsmod_phase(const Params& p, int layer, int hb) {
  const int tid = get_tid(), w = tid >> 6, lane = tid & 63;
  for (int lr = blockIdx.x * 8 + w; lr < HR; lr += gridDim.x * 8) {
    const float* src; int r;
    if (lr < HL) {
      size_t grow = (size_t)hb * HL + lr;
      src = (layer == 0 ? p.x : (const float*)p.out) + grow * 1024;
      r = hb * 4 + (lr >> 12);
    } else {
      size_t g = (size_t)hb * 1024 + (lr - HL);
      src = (layer == 0 ? p.ctx : (const float*)p.x1c) + g * 1024;
      r = 8;
    }
    float4 v[4];
    float ss = 0.f;
#pragma unroll
    for (int i = 0; i < 4; ++i) {
      v[i] = *(const float4*)(src + lane * 4 + 256 * i);
      ss += v[i].x * v[i].x + v[i].y * v[i].y + v[i].z * v[i].z + v[i].w * v[i].w;
    }
#pragma unroll
    for (int o = 32; o >= 1; o >>= 1) ss += __shfl_xor(ss, o);
    const float rstd = rsqrtf(ss * (1.f / 1024.f) + EPSF);
    const float* ada = p.ada + (layer * 9 + r) * 3072;
    const float* nw = p.norm_w + layer * 1024;
#pragma unroll
    for (int i = 0; i < 4; ++i) {
      int col = lane * 4 + 256 * i;
      float4 sh = *(const float4*)(ada + col);
      float4 sc = *(const float4*)(ada + 1024 + col);
      float4 nv = *(const float4*)(nw + col);
      float o0 = v[i].x * rstd * nv.x * (1.f + sc.x) + sh.x;
      float o1 = v[i].y * rstd * nv.y * (1.f + sc.y) + sh.y;
      float o2 = v[i].z * rstd * nv.z * (1.f + sc.z) + sh.z;
      float o3 = v[i].w * rstd * nv.w * (1.f + sc.w) + sh.w;
      u32x2 pk; pk[0] = pack2(o0, o1); pk[1] = pack2(o2, o3);
      *(u32x2*)(p.H + (size_t)lr * 1024 + col) = pk;
    }
  }
}

#define LAS __attribute__((address_space(3)))
constexpr int G_HALF = 128, G_HTB = 128 * 64 * 2;
DI int lds_byte(int r, int c) { const int st = (r >> 4) * 2 + (c >> 5), rr = r & 15, cc = c & 31, ob = rr * 64 + cc * 2; return st * 1024 + (ob ^ (((ob >> 9) & 1) << 5)); }
DI void stage_rc(int b, int& R, int& C) { const int st = b / 1024, sb = b % 1024, swz = sb ^ (((sb >> 9) & 1) << 5); R = (st >> 1) * 16 + swz / 64; C = (st & 1) * 32 + (swz % 64) / 2; }
DI int perm32(int rho) { const int n = rho >> 4, i = rho & 15; return 8 * (i >> 2) + 4 * n + (i & 3); }
struct Unit { int pm, pn; };
struct Order {
  int nM, nN, nwg, G, c;
  DI void init(int nM_, int nN_, int G_, int c_) { nM = nM_; nN = nN_; nwg = nM * nN; G = G_; c = c_; }
  DI bool next(int i, Unit& u) const {
    const long L = (long)i * G + c; if (L >= nwg) return false;
    int wgid = (int)L; { const int q = nwg / 8, r = nwg % 8, xcd = wgid % 8, off = wgid / 8; wgid = (xcd < r ? xcd * (q + 1) : r * (q + 1) + (xcd - r) * q) + off; }
    const int nig = 8 * nN, gid = wgid / nig, fm = gid * 8, gsz = (nM - fm) < 8 ? (nM - fm) : 8;
    u.pm = fm + ((wgid % nig) % gsz); u.pn = (wgid % nig) / gsz; return true;
  }
};
struct GemmArgs { const u16* A; int lda; const u16* Bt; int K; int nM, nN; };

struct Epi1 {
  static constexpr bool PERM = true;
  u16* P; float* G; const float* b_gate;
  DI void operator()(const f32x4 (&acc)[2][2][4][2], const Unit& u, int wr, int wc, int fr, int fq) const {
    const int row0 = u.pm * 256 + wr * 64 + fr;
    if (u.pn >= 16 && u.pn < 24 && u.pm * 256 < HL) {
      const int col0 = u.pn * 256 + wc * 32 + 8 * fq;
      int frl = fr, fql = fq;
      asm volatile("" : "+v"(frl), "+v"(fql));
      float fr4[4];
#pragma unroll
      for (int jj = 0; jj < 4; ++jj) fr4[jj] = __builtin_amdgcn_exp2f(-(float)(wc * 16 + 4 * fql + jj) * (13.287712379549449f / 64.f));
#pragma unroll
      for (int ai = 0; ai < 2; ++ai) {
        const float pos = (float)(((row0 + ai * 128) & 4095) >> 6);
        float cs[4], sn[4];
#pragma unroll
        for (int jj = 0; jj < 4; ++jj) { const float ang = pos * fr4[jj]; cs[jj] = __cosf(ang); sn[jj] = __sinf(ang); }
#pragma unroll
        for (int m = 0; m < 4; ++m) {
          const f32x4 v0 = acc[ai][0][m][0], v1 = acc[ai][0][m][1];
          u32x4 ov;
          ov[0] = pack2(v0[0] * cs[0] - v0[1] * sn[0], v0[1] * cs[0] + v0[0] * sn[0]);
          ov[1] = pack2(v0[2] * cs[1] - v0[3] * sn[1], v0[3] * cs[1] + v0[2] * sn[1]);
          ov[2] = pack2(v1[0] * cs[2] - v1[1] * sn[2], v1[1] * cs[2] + v1[0] * sn[2]);
          ov[3] = pack2(v1[2] * cs[3] - v1[3] * sn[3], v1[3] * cs[3] + v1[2] * sn[3]);
          *(u32x4*)(P + (size_t)(row0 + ai * 128 + m * 16) * S0 + col0) = ov;
        }
        __builtin_amdgcn_sched_barrier(0);
      }
#pragma unroll
      for (int m = 0; m < 4; ++m) {
        const float pos = (float)(frl + 16 * m);
        float cs[4], sn[4];
#pragma unroll
        for (int jj = 0; jj < 4; ++jj) { const float ang = pos * fr4[jj]; cs[jj] = __cosf(ang); sn[jj] = __sinf(ang); }
#pragma unroll
        for (int ai = 0; ai < 2; ++ai) {
          const f32x4 v0 = acc[ai][1][m][0], v1 = acc[ai][1][m][1];
          u32x4 ov;
          ov[0] = pack2(v0[0] * cs[0] - v0[1] * sn[0], v0[1] * cs[0] + v0[0] * sn[0]);
          ov[1] = pack2(v0[2] * cs[1] - v0[3] * sn[1], v0[3] * cs[1] + v0[2] * sn[1]);
          ov[2] = pack2(v1[0] * cs[2] - v1[1] * sn[2], v1[1] * cs[2] + v1[0] * sn[2]);
          ov[3] = pack2(v1[2] * cs[3] - v1[3] * sn[3], v1[3] * cs[3] + v1[2] * sn[3]);
          *(u32x4*)(P + (size_t)(row0 + ai * 128 + m * 16) * S0 + col0 + 128) = ov;
        }
        __builtin_amdgcn_sched_barrier(0);
      }
    } else if (u.pn < 36) {
      const int col0 = u.pn * 256 + wc * 32 + 8 * fq;
#pragma unroll
      for (int ai = 0; ai < 2; ++ai)
#pragma unroll
        for (int m = 0; m < 4; ++m) {
          u16* rowp = P + (size_t)(row0 + ai * 128 + m * 16) * S0 + col0;
#pragma unroll
          for (int bj = 0; bj < 2; ++bj) {
            const f32x4 v0 = acc[ai][bj][m][0], v1 = acc[ai][bj][m][1];
            u32x4 o; o[0] = pack2(v0[0], v0[1]); o[1] = pack2(v0[2], v0[3]); o[2] = pack2(v1[0], v1[1]); o[3] = pack2(v1[2], v1[3]);
            *(u32x4*)(rowp + bj * 128) = o;
          }
        }
    } else if (wc == 0 && fq < 2) {
      const f32x4 b0 = *(const f32x4*)(b_gate + 8 * fq), b1 = *(const f32x4*)(b_gate + 8 * fq + 4);
#pragma unroll
      for (int ai = 0; ai < 2; ++ai)
#pragma unroll
        for (int m = 0; m < 4; ++m) {
          float* g = G + (size_t)(row0 + ai * 128 + m * 16) * 16 + 8 * fq;
          *(f32x4*)g = acc[ai][0][m][0] + b0;
          *(f32x4*)(g + 4) = acc[ai][0][m][1] + b1;
        }
    }
  }
};
struct Epi3 {
  static constexpr bool PERM = true;
  u16* P; const float* lb_c;
  DI void operator()(const f32x4 (&acc)[2][2][4][2], const Unit& u, int wr, int wc, int fr, int fq) const {
    const int row0 = u.pm * 256 + wr * 64 + fr;
    const int col0 = u.pn * 256 + wc * 32 + 8 * fq;
    const int type = u.pn >> 3;
    float lbv[2][8];
    if (type == 1 || type == 2) {
#pragma unroll
      for (int bj = 0; bj < 2; ++bj)
#pragma unroll
        for (int j = 0; j < 8; ++j) { const int cc = (col0 + bj * 128 + j) & 2047; lbv[bj][j] = rcpf_(1.f + __expf(lb_c[cc] - lb_c[2048 + cc])); }
    } else {
#pragma unroll
      for (int bj = 0; bj < 2; ++bj)
#pragma unroll
        for (int j = 0; j < 8; ++j) lbv[bj][j] = 0.f;
    }
#pragma unroll
    for (int ai = 0; ai < 2; ++ai)
#pragma unroll
      for (int m = 0; m < 4; ++m) {
        u16* rowp = P + (size_t)(row0 + ai * 128 + m * 16) * S1 + col0;
#pragma unroll
        for (int bj = 0; bj < 2; ++bj) {
          float v[8];
#pragma unroll
          for (int j = 0; j < 4; ++j) { v[j] = acc[ai][bj][m][0][j]; v[4 + j] = acc[ai][bj][m][1][j]; }
          if (type == 0) {
#pragma unroll
            for (int j = 0; j < 8; ++j) v[j] = siluf_(v[j]);
          } else if (type == 1 || type == 2) {
#pragma unroll
            for (int j = 0; j < 8; ++j) v[j] = fastlogf_(lbv[bj][j] + (1.f - lbv[bj][j]) * sigmoidf_(v[j]));
          }
          u32x4 o; o[0] = pack2(v[0], v[1]); o[1] = pack2(v[2], v[3]); o[2] = pack2(v[4], v[5]); o[3] = pack2(v[6], v[7]);
          *(u32x4*)(rowp + bj * 128) = o;
        }
      }
  }
};
struct EpiRes {
  static constexpr bool PERM = false;
  const float* x; const float* ctx; float* out; float* x1c; const float* ada; int hb; int layer;
  DI void operator()(const f32x4 (&acc)[2][2][4][2], const Unit& u, int wr, int wc, int fr, int fq) const {
    const int lr0 = u.pm * 256;
    const float* xin; float* dst; const float* gate;
    if (lr0 < HL) {
      const size_t g0 = ((size_t)hb * HL + lr0) * 1024;
      xin = (layer == 0 ? x : (const float*)out) + g0; dst = out + g0;
      gate = ada + (layer * 9 + hb * 4 + (lr0 >> 12)) * 3072 + 2048;
    } else {
      const size_t g0 = ((size_t)hb * 1024 + (lr0 - HL)) * 1024;
      xin = ctx + g0; dst = x1c + g0;
      gate = ada + (layer * 9 + 8) * 3072 + 2048;
    }
    const int col0 = u.pn * 256 + wc * 32 + 4 * fq;
    f32x4 gv[2][2];
#pragma unroll
    for (int bj = 0; bj < 2; ++bj)
#pragma unroll
      for (int n = 0; n < 2; ++n) gv[bj][n] = *(const f32x4*)(gate + col0 + bj * 128 + n * 16);
#pragma unroll
    for (int ai = 0; ai < 2; ++ai)
#pragma unroll
      for (int m = 0; m < 4; ++m) {
        const size_t off = (size_t)(wr * 64 + fr + ai * 128 + m * 16) * 1024 + col0;
#pragma unroll
        for (int bj = 0; bj < 2; ++bj)
#pragma unroll
          for (int n = 0; n < 2; ++n) {
            const f32x4 xv = *(const f32x4*)(xin + off + bj * 128 + n * 16);
            *(f32x4*)(dst + off + bj * 128 + n * 16) = xv + gv[bj][n] * acc[ai][bj][m][n];
          }
      }
  }
};

template <class Epi>
static __device__ __forceinline__ void gemm_phase(const GemmArgs g, const Epi& E) {
  LAS unsigned char* lds = (LAS unsigned char*)smem;
  const int tid = get_tid(), wid = __builtin_amdgcn_readfirstlane(tid >> 6), lane = tid & 63, wr = wid >> 2, wc = wid & 3, fr = lane & 15, fq = lane >> 4;
  const int K = g.K, nt = K / 64;
  Order S; S.init(g.nM, g.nN, gridDim.x, get_bid());
  unsigned voffA[2], voffB[2];
#pragma unroll
  for (int i = 0; i < 2; ++i) {
    int R, C; stage_rc(tid * 16 + i * 8192, R, C);
    const int Rb = Epi::PERM ? ((R & ~31) + perm32(R & 31)) : R;
    voffA[i] = (unsigned)(R * g.lda + C) * 2u; voffB[i] = (unsigned)(Rb * K + C) * 2u;
  }
  const size_t kstep = 128;
  const size_t hstepA = (size_t)G_HALF * g.lda * 2, hstepB = (size_t)G_HALF * K * 2;
  const size_t tstepA = 2 * hstepA, tstepB = 2 * hstepB;
  const unsigned ldsw = (unsigned)wid * 1024u;
  const int aoff = lds_byte(wr * 64 + fr, fq * 8), boff = lds_byte(wc * 32 + fr, fq * 8);
#define PG8_SA(b, h) (((b) * 2 + (h)) * G_HTB)
#define PG8_SB(b, h) ((4 + (b) * 2 + (h)) * G_HTB)
#define PG8_STAGE(bufoff, gbase, voff) do { _Pragma("unroll") for (int _i = 0; _i < 2; ++_i) \
    __builtin_amdgcn_global_load_lds((const unsigned*)((const char*)(gbase) + (voff)[_i]), (LAS unsigned*)(lds + (bufoff) + ldsw + _i * 8192), 16, 0, 0); } while (0)
#define PG8_LDA(dst, b, h) do { _Pragma("unroll") for (int m = 0; m < 4; ++m) _Pragma("unroll") for (int k = 0; k < 2; ++k) dst[m][k] = *(const LAS bf16x8*)(lds + PG8_SA(b, h) + aoff + m * 2048 + k * 1024); } while (0)
#define PG8_LDB(dst, b, h) do { _Pragma("unroll") for (int n = 0; n < 2; ++n) _Pragma("unroll") for (int k = 0; k < 2; ++k) dst[n][k] = *(const LAS bf16x8*)(lds + PG8_SB(b, h) + boff + n * 2048 + k * 1024); } while (0)
#define PG8_MMA(ai, bj, At, Bt) do { __builtin_amdgcn_s_setprio(1); _Pragma("unroll") for (int m = 0; m < 4; ++m) _Pragma("unroll") for (int n = 0; n < 2; ++n) _Pragma("unroll") for (int k = 0; k < 2; ++k) \
    acc[ai][bj][m][n] = __builtin_amdgcn_mfma_f32_16x16x32_bf16(Bt[n][k], At[m][k], acc[ai][bj][m][n], 0, 0, 0); __builtin_amdgcn_s_setprio(0); } while (0)
#define PG8_WAIT_V(n) asm volatile("s_waitcnt vmcnt(" #n ")" ::: "memory")
#define PG8_WAIT_L(n) asm volatile("s_waitcnt lgkmcnt(" #n ")" ::: "memory")
#define PG8_BAR __builtin_amdgcn_s_barrier()
#define PG8_SCHED __builtin_amdgcn_sched_barrier(0)
  Unit cur, nxt; int ui = 0;
  if (S.next(0, cur)) {
  f32x4 acc[2][2][4][2];
#pragma unroll
  for (int a = 0; a < 2; ++a)
#pragma unroll
    for (int b = 0; b < 2; ++b)
#pragma unroll
      for (int m = 0; m < 4; ++m)
#pragma unroll
        for (int n = 0; n < 2; ++n) acc[a][b][m][n] = zero4();
  bf16x8 At[4][2], B0[2][2], B1[2][2];
  const char* cA = (const char*)g.A + (size_t)cur.pm * tstepA; const char* cB = (const char*)g.Bt + (size_t)cur.pn * tstepB;
  PG8_STAGE(PG8_SB(0, 0), cB, voffB); PG8_STAGE(PG8_SA(0, 0), cA, voffA); PG8_STAGE(PG8_SB(0, 1), cB + hstepB, voffB); PG8_STAGE(PG8_SA(0, 1), cA + hstepA, voffA);
  if (wr == 1) PG8_BAR;
  PG8_WAIT_V(4); PG8_BAR;
  PG8_STAGE(PG8_SB(1, 0), cB + kstep, voffB); PG8_STAGE(PG8_SA(1, 0), cA + kstep, voffA); PG8_STAGE(PG8_SB(1, 1), cB + hstepB + kstep, voffB);
  PG8_WAIT_V(6); PG8_BAR;
  for (;;) {
    const bool has_next = S.next(ui + 1, nxt);
    const char* nA = has_next ? (const char*)g.A + (size_t)nxt.pm * tstepA : cA; const char* nB = has_next ? (const char*)g.Bt + (size_t)nxt.pn * tstepB : cB;
    for (int t = 0; t < nt; t += 2) {
      const bool last = (t == nt - 2);
      const char* a1 = cA + (size_t)(t + 1) * kstep;
      const char* a2 = last ? nA : cA + (size_t)(t + 2) * kstep; const char* b2 = last ? nB : cB + (size_t)(t + 2) * kstep;
      const char* a3 = a2 + kstep; const char* b3 = b2 + kstep;
      PG8_LDB(B0, 0, 0); PG8_SCHED; PG8_LDA(At, 0, 0); PG8_STAGE(PG8_SA(1, 1), a1 + hstepA, voffA);
      PG8_WAIT_L(8); PG8_BAR; PG8_WAIT_L(0); PG8_MMA(0, 0, At, B0); PG8_BAR; PG8_SCHED;
      PG8_LDB(B1, 0, 1); PG8_STAGE(PG8_SB(0, 0), b2, voffB);
      PG8_BAR; PG8_WAIT_L(0); PG8_MMA(0, 1, At, B1); PG8_BAR;
      PG8_LDA(At, 0, 1); PG8_STAGE(PG8_SA(0, 0), a2, voffA);
      PG8_BAR; PG8_WAIT_L(0); PG8_MMA(1, 0, At, B0); PG8_BAR; PG8_SCHED;
      PG8_STAGE(PG8_SB(0, 1), b2 + hstepB, voffB);
      PG8_WAIT_V(6); PG8_BAR; PG8_MMA(1, 1, At, B1); PG8_BAR;
      PG8_LDB(B0, 1, 0); PG8_SCHED; PG8_LDA(At, 1, 0); PG8_STAGE(PG8_SA(0, 1), a2 + hstepA, voffA);
      PG8_WAIT_L(8); PG8_BAR; PG8_WAIT_L(0); PG8_MMA(0, 0, At, B0); PG8_BAR; PG8_SCHED;
      PG8_LDB(B1, 1, 1); PG8_STAGE(PG8_SB(1, 0), b3, voffB);
      PG8_BAR; PG8_WAIT_L(0); PG8_MMA(0, 1, At, B1); PG8_BAR;
      PG8_LDA(At, 1, 1); PG8_STAGE(PG8_SA(1, 0), a3, voffA);
      PG8_BAR; PG8_WAIT_L(0); PG8_MMA(1, 0, At, B0); PG8_BAR; PG8_SCHED;
      PG8_STAGE(PG8_SB(1, 1), b3 + hstepB, voffB);
      PG8_WAIT_V(6); PG8_BAR; PG8_MMA(1, 1, At, B1); PG8_BAR;
    }
    E(acc, cur, wr, wc, fr, fq);
    if (!has_next) break;
#pragma unroll
    for (int a = 0; a < 2; ++a)
#pragma unroll
      for (int b = 0; b < 2; ++b)
#pragma unroll
        for (int m = 0; m < 4; ++m)
#pragma unroll
          for (int n = 0; n < 2; ++n) acc[a][b][m][n] = zero4();
    cur = nxt; cA = nA; cB = nB; ++ui;
  }
  PG8_WAIT_V(0);
  if (wr == 0) PG8_BAR;
  PG8_BAR;
  }
#undef PG8_SA
#undef PG8_SB
#undef PG8_STAGE
#undef PG8_LDA
#undef PG8_LDB
#undef PG8_MMA
#undef PG8_WAIT_V
#undef PG8_WAIT_L
#undef PG8_BAR
#undef PG8_SCHED
}

constexpr int NA_UNITS = 1024 + 64;
static __device__ __forceinline__ void na_unit(const Params& p, int unit) {
  u16* P = p.P;
  u16* Ks = (u16*)smem;
  u16* Vt = Ks + 2 * 4608;
  float* rpb_s = (float*)(Vt + 2 * 4352);
  const int tid = get_tid(), w = tid >> 6, lane = tid & 63, fr = lane & 15, fq = lane >> 4;
  const bool isctx = unit >= 1024;
  int bl, h, rq = 0;
  if (!isctx) { bl = unit >> 8; h = (unit >> 4) & 15; rq = unit & 15; }
  else { const int u = unit - 1024; bl = u >> 4; h = u & 15; }
  const int col = (w & 3) * 16 + fr;
  int rr[2], lrq[2], r0s[2];
#pragma unroll
  for (int sx = 0; sx < 2; ++sx) {
    rr[sx] = 4 * rq + (w >> 2) + 2 * sx;
    lrq[sx] = isctx ? (HL + bl * 256 + sx * 128 + w * 16 + fr) : (bl * 4096 + rr[sx] * 64 + col);
    r0s[sx] = min(max(rr[sx] - 4, 0), 56);
  }
  const int r0a = min(max(4 * rq - 4, 0), 56), r0b = min(max(4 * rq - 1, 0), 56);
  const int nlat = isctx ? 0 : (r0b + 8 - r0a);
  const int nt = nlat + 4;
  if (!isctx) for (int i = tid; i < 465; i += NT) rpb_s[i] = p.rpb[h * 465 + i];
  bf16x8 qf[2][2];
#pragma unroll
  for (int sx = 0; sx < 2; ++sx) {
    u32x4 qr[2];
    float qv[2][8];
    float ss = 0.f;
#pragma unroll
    for (int ks = 0; ks < 2; ++ks) {
      qr[ks] = *(const u32x4*)(P + (size_t)lrq[sx] * S0 + h * 64 + ks * 32 + fq * 8);
#pragma unroll
      for (int j = 0; j < 4; ++j) { qv[ks][2 * j] = lo2f(qr[ks][j]); qv[ks][2 * j + 1] = hi2f(qr[ks][j]); }
#pragma unroll
      for (int j = 0; j < 8; ++j) ss += qv[ks][j] * qv[ks][j];
    }
    ss += __shfl_xor(ss, 16);
    ss += __shfl_xor(ss, 32);
    const float rstd = rsqrtf(ss * (1.f / 64.f) + EPSF) * 0.125f;
#pragma unroll
    for (int ks = 0; ks < 2; ++ks) {
      const float* qn = p.q_norm + ks * 32 + fq * 8;
      u32x4 o;
#pragma unroll
      for (int j = 0; j < 4; ++j) o[j] = pack2(qv[ks][2 * j] * rstd * qn[2 * j], qv[ks][2 * j + 1] * rstd * qn[2 * j + 1]);
      qf[sx][ks] = __builtin_bit_cast(bf16x8, o);
    }
  }
  f32x4 ot[2][4];
  float mrun[2], lrun[2];
#pragma unroll
  for (int sx = 0; sx < 2; ++sx) {
    mrun[sx] = -INFINITY; lrun[sx] = 0.f;
#pragma unroll
    for (int d = 0; d < 4; ++d) ot[sx][d] = zero4();
  }
  const int lkey = tid >> 3, lc = tid & 7;
  u32x4 kreg, vreg;
  auto gload = [&](int i) {
    int lrk = (i < nlat) ? (bl * 4096 + (r0a + i) * 64 + lkey) : (HL + bl * 256 + (i - nlat) * 64 + lkey);
    const u16* base = P + (size_t)lrk * S0 + h * 64 + lc * 8;
    kreg = *(const u32x4*)(base + 1024);
    vreg = *(const u32x4*)(base + 2048);
  };
  float knw[8];
#pragma unroll
  for (int j = 0; j < 8; ++j) knw[j] = p.k_norm[lc * 8 + j];
  auto sstore = [&](int buf) {
    {
      float kv[8];
      float ss = 0.f;
#pragma unroll
      for (int j = 0; j < 4; ++j) { kv[2 * j] = lo2f(kreg[j]); kv[2 * j + 1] = hi2f(kreg[j]); }
#pragma unroll
      for (int j = 0; j < 8; ++j) ss += kv[j] * kv[j];
      ss += __shfl_xor(ss, 1); ss += __shfl_xor(ss, 2); ss += __shfl_xor(ss, 4);
      const float rstd = rsqrtf(ss * (1.f / 64.f) + EPSF);
#pragma unroll
      for (int j = 0; j < 4; ++j) kreg[j] = pack2(kv[2 * j] * rstd * knw[2 * j], kv[2 * j + 1] * rstd * knw[2 * j + 1]);
    }
    *(u32x4*)(Ks + buf * 4608 + lkey * 72 + lc * 8) = kreg;
    u16* vt = Vt + buf * 4352 + (lc * 8) * 68 + lkey;
#pragma unroll
    for (int j = 0; j < 4; ++j) {
      vt[(2 * j) * 68] = (u16)(vreg[j] & 0xFFFFu);
      vt[(2 * j + 1) * 68] = (u16)(vreg[j] >> 16);
    }
  };
  gload(0);
  sstore(0);
  __syncthreads();
  for (int i = 0; i < nt; ++i) {
    if (i + 1 < nt) gload(i + 1);
    const int kr = r0a + i;
    const u16* Kb = Ks + (i & 1) * 4608;
    const u16* Vb = Vt + (i & 1) * 4352;
#pragma unroll
    for (int sx = 0; sx < 2; ++sx) {
      const bool active = (i >= nlat) || (kr >= r0s[sx] && kr <= r0s[sx] + 7);
      if (active) {
        f32x4 st[4];
#pragma unroll
        for (int kt = 0; kt < 4; ++kt) {
          st[kt] = zero4();
#pragma unroll
          for (int ks = 0; ks < 2; ++ks) {
            bf16x8 kf = *(const bf16x8*)(Kb + (kt * 16 + fr) * 72 + ks * 32 + fq * 8);
            st[kt] = MFMA16(kf, qf[sx][ks], st[kt]);
          }
        }
        if (i < nlat) {
          const int c0 = min(max(col - 8, 0), 48);
          const float* rb = rpb_s + (kr - rr[sx] + 7) * 31 + 15 - col;
          float bv[4][4];
#pragma unroll
          for (int kt = 0; kt < 4; ++kt)
#pragma unroll
            for (int e = 0; e < 4; ++e) bv[kt][e] = rb[kt * 16 + fq * 4 + e];
#pragma unroll
          for (int kt = 0; kt < 4; ++kt) asm volatile("" : "+v"(bv[kt][0]), "+v"(bv[kt][1]), "+v"(bv[kt][2]), "+v"(bv[kt][3]));
#pragma unroll
          for (int kt = 0; kt < 4; ++kt)
#pragma unroll
            for (int e = 0; e < 4; ++e) {
              const int kc = kt * 16 + fq * 4 + e;
              const bool valid = (kc >= c0) && (kc < c0 + 16);
              st[kt][e] = valid ? (st[kt][e] + bv[kt][e]) : -INFINITY;
            }
        }
        float mx = -INFINITY;
#pragma unroll
        for (int kt = 0; kt < 4; ++kt)
#pragma unroll
          for (int e = 0; e < 4; ++e) mx = fmaxf(mx, st[kt][e]);
        mx = fmaxf(mx, __shfl_xor(mx, 16));
        mx = fmaxf(mx, __shfl_xor(mx, 32));
        const float mnew = fmaxf(mrun[sx], mx);
        const float alpha = __expf(mrun[sx] - mnew);
        mrun[sx] = mnew;
        lrun[sx] *= alpha;
#pragma unroll
        for (int d = 0; d < 4; ++d) ot[sx][d] *= alpha;
        float pe[4][4];
#pragma unroll
        for (int kt = 0; kt < 4; ++kt)
#pragma unroll
          for (int e = 0; e < 4; ++e) { pe[kt][e] = __expf(st[kt][e] - mnew); lrun[sx] += pe[kt][e]; }
#pragma unroll
        for (int kk = 0; kk < 2; ++kk) {
          u32x4 pp;
          pp[0] = pack2(pe[2 * kk][0], pe[2 * kk][1]); pp[1] = pack2(pe[2 * kk][2], pe[2 * kk][3]);
          pp[2] = pack2(pe[2 * kk + 1][0], pe[2 * kk + 1][1]); pp[3] = pack2(pe[2 * kk + 1][2], pe[2 * kk + 1][3]);
          const bf16x8 pf = __builtin_bit_cast(bf16x8, pp);
#pragma unroll
          for (int d = 0; d < 4; ++d) {
            const u16* vrow = Vb + (d * 16 + fr) * 68 + kk * 32 + fq * 4;
            u32x2 lo = *(const u32x2*)vrow, hi = *(const u32x2*)(vrow + 16);
            u32x4 vv; vv[0] = lo[0]; vv[1] = lo[1]; vv[2] = hi[0]; vv[3] = hi[1];
            ot[sx][d] = MFMA16(__builtin_bit_cast(bf16x8, vv), pf, ot[sx][d]);
          }
        }
      }
    }
    if (i + 1 < nt) sstore((i + 1) & 1);
    __syncthreads();
  }
#pragma unroll
  for (int sx = 0; sx < 2; ++sx) {
    float l = lrun[sx];
    l += __shfl_xor(l, 16);
    l += __shfl_xor(l, 32);
    const float inv = rcpf_(l);
#pragma unroll
    for (int d = 0; d < 4; ++d) {
      const int dim = d * 16 + fq * 4;
      u16* qz = P + (size_t)lrq[sx] * S0 + h * 64 + dim;
      u32x2 z = *(const u32x2*)(qz + 3072);
      float y0 = ot[sx][d][0] * inv * siluf_(lo2f(z[0]));
      float y1 = ot[sx][d][1] * inv * siluf_(hi2f(z[0]));
      float y2 = ot[sx][d][2] * inv * siluf_(lo2f(z[1]));
      float y3 = ot[sx][d][3] * inv * siluf_(hi2f(z[1]));
      u32x2 o; o[0] = pack2(y0, y1); o[1] = pack2(y2, y3);
      *(u32x2*)qz = o;
    }
  }
}

static __device__ __forceinline__ void mlstm_unit(const Params& p, int unit) {
  const u16* P = p.P;
  u16* Qs = (u16*)smem;
  u16* Ks = Qs + 64 * 264;
  u16* KT = Ks + 64 * 264;
  u16* VT = KT + 256 * 72;
  u16* CT = VT + 80 * 72;
  u16* Ps = Qs;
  u16* VTW = Ks;
  const int tid = get_tid(), w = tid >> 6, lane = tid & 63, fr = lane & 15, fq = lane >> 4;
  const int vs = unit & 3, dir = (unit >> 2) & 1, h = (unit >> 3) & 3, bl = unit >> 5;
  const int ti = w & 3, g = w >> 2;
  for (int i = tid; i < 80 * 264; i += NT) CT[i] = 0;
  for (int i = tid; i < 16 * 72; i += NT) VT[64 * 72 + i] = (i < 72) ? (u16)0x3F80 : (u16)0;
  f32x4 ct[5][2];
#pragma unroll
  for (int a = 0; a < 5; ++a) { ct[a][0] = zero4(); ct[a][1] = zero4(); }
  float m = 0.f;
  const int dvt[3] = {2 * g, 2 * g + 1, 4};
  const int cq = tid & 15;
  const int kch0 = 2 * lane;
  const int vvp = tid & 31, vgg = (tid >> 5) & 7;
#define MROW_LOW(cc) (((cc) < 4) ? (HL + bl * 256 + (dir ? 192 - (cc) * 64 : (cc) * 64)) : (bl * 4096 + (dir ? 4032 - ((cc) - 4) * 64 : ((cc) - 4) * 64)))
#define PIDX(pp) (dir ? 63 - (pp) : (pp))
  unsigned qoffB[2], koffB[8], voffB[8];
#pragma unroll
  for (int i = 0; i < 2; ++i) qoffB[i] = (unsigned)(PIDX((tid + NT * i) >> 4) * S0 + 4096 + h * 256 + cq * 8) * 2u;
#pragma unroll
  for (int j = 0; j < 8; ++j) {
    koffB[j] = (unsigned)(PIDX(w * 8 + j) * S0 + 5120 + h * 256 + kch0) * 2u;
    voffB[j] = (unsigned)(PIDX(vgg * 8 + j) * S0 + 6144 + h * 256 + vs * 64 + 2 * vvp) * 2u;
  }
  const unsigned goffB = (unsigned)(PIDX(lane) * 16 + 2 * dir * 4 + h) * 4u;
#define MLOAD(rl, QLO, QHI, K1, K2, VV, IG, FG) do { \
    const char* pb_ = (const char*)(P + (size_t)(rl) * S0); const char* gb_ = (const char*)(p.G + (size_t)(rl) * 16); \
    _Pragma("unroll") for (int i = 0; i < 2; ++i) { QLO[i] = *(const u32x4*)(pb_ + qoffB[i]); QHI[i] = *(const u32x4*)(pb_ + qoffB[i] + 256); } \
    _Pragma("unroll") for (int j = 0; j < 8; ++j) { K1[j] = *(const unsigned*)(pb_ + koffB[j]); K2[j] = *(const unsigned*)(pb_ + koffB[j] + 256); } \
    _Pragma("unroll") for (int j = 0; j < 8; ++j) VV[j] = *(const unsigned*)(pb_ + voffB[j]); \
    IG = *(const float*)(gb_ + goffB); FG = *(const float*)(gb_ + goffB + 16); } while (0)
  u32x4 qlo[2], qhi[2];
  unsigned k1[8], k2[8], vv[8];
  float ig, fg;
  { const int rl0 = MROW_LOW(0); MLOAD(rl0, qlo, qhi, k1, k2, vv, ig, fg); }
  __syncthreads();
  for (int c = 0; c < 68; ++c) {
    const int rlow = MROW_LOW(c);
#define rowof(pp) (rlow + PIDX(pp))
    u32x4 qlon[2], qhin[2];
    unsigned k1n[8], k2n[8], vvn[8];
    float ign, fgn;
    { const int cn = (c + 1 < 68) ? c + 1 : c; const int rln = MROW_LOW(cn); MLOAD(rln, qlon, qhin, k1n, k2n, vvn, ign, fgn); }
    const float lf = fminf(fg, 0.f) - fastlogf_(1.f + __expf(-fabsf(fg)));
    const float bcs = wave_scan_add(lf);
    const float av = ig - bcs;
    const float uv = wave_scan_max(av);
    const float Mv = fmaxf(uv, m);
    const float M63 = __shfl(Mv, 63), bL = __shfl(bcs, 63);
    const float wsc = __expf(av - M63);
#pragma unroll
    for (int i = 0; i < 2; ++i) {
      const int pp = (tid + NT * i) >> 4;
      *(u32x4*)(Qs + pp * 264 + cq * 8) = qlo[i];
      *(u32x4*)(Qs + pp * 264 + cq * 8 + 128) = qhi[i];
    }
    {
#pragma unroll
      for (int j = 0; j < 8; ++j) {
        *(unsigned*)(Ks + (w * 8 + j) * 264 + kch0) = k1[j];
        *(unsigned*)(Ks + (w * 8 + j) * 264 + kch0 + 128) = k2[j];
      }
      float ws8[8];
#pragma unroll
      for (int j = 0; j < 8; ++j) ws8[j] = __shfl(wsc, w * 8 + j);
      u32x4 lo, hi;
#pragma unroll
      for (int j = 0; j < 4; ++j) {
        lo[j] = pack2(lo2f(k1[2 * j]) * ws8[2 * j], lo2f(k1[2 * j + 1]) * ws8[2 * j + 1]);
        hi[j] = pack2(hi2f(k1[2 * j]) * ws8[2 * j], hi2f(k1[2 * j + 1]) * ws8[2 * j + 1]);
      }
      *(u32x4*)(KT + (kch0) * 72 + w * 8) = lo;
      *(u32x4*)(KT + (kch0 + 1) * 72 + w * 8) = hi;
#pragma unroll
      for (int j = 0; j < 4; ++j) {
        lo[j] = pack2(lo2f(k2[2 * j]) * ws8[2 * j], lo2f(k2[2 * j + 1]) * ws8[2 * j + 1]);
        hi[j] = pack2(hi2f(k2[2 * j]) * ws8[2 * j], hi2f(k2[2 * j + 1]) * ws8[2 * j + 1]);
      }
      *(u32x4*)(KT + (kch0 + 128) * 72 + w * 8) = lo;
      *(u32x4*)(KT + (kch0 + 129) * 72 + w * 8) = hi;
    }
    if (tid < 256) {
      u32x4 lo, hi;
#pragma unroll
      for (int j = 0; j < 4; ++j) {
        lo[j] = (vv[2 * j] & 0xFFFFu) | (vv[2 * j + 1] << 16);
        hi[j] = (vv[2 * j] >> 16) | (vv[2 * j + 1] & 0xFFFF0000u);
      }
      *(u32x4*)(VT + (2 * vvp) * 72 + vgg * 8) = lo;
      *(u32x4*)(VT + (2 * vvp + 1) * 72 + vgg * 8) = hi;
    }
    __syncthreads();
    f32x4 acc3[3], s2[2];
#pragma unroll
    for (int j = 0; j < 3; ++j) acc3[j] = zero4();
    s2[0] = zero4(); s2[1] = zero4();
#pragma unroll 4
    for (int ks = 0; ks < 8; ++ks) {
      const bf16x8 qf = *(const bf16x8*)(Qs + (ti * 16 + fr) * 264 + ks * 32 + fq * 8);
#pragma unroll
      for (int j = 0; j < 3; ++j) {
        const bf16x8 cf = *(const bf16x8*)(CT + (dvt[j] * 16 + fr) * 264 + ks * 32 + fq * 8);
        acc3[j] = MFMA16(cf, qf, acc3[j]);
      }
#pragma unroll
      for (int jj = 0; jj < 2; ++jj) {
        if (2 * g + jj <= ti) {
          const bf16x8 kf = *(const bf16x8*)(Ks + ((2 * g + jj) * 16 + fr) * 264 + ks * 32 + fq * 8);
          s2[jj] = MFMA16(kf, qf, s2[jj]);
        }
      }
    }
    const int tq = ti * 16 + fr;
    const float Mt = __shfl(Mv, tq);
    const float cw = __expf(m - Mt);
    const float bt = __shfl(bcs, tq);
    __syncthreads();
#pragma unroll
    for (int jj = 0; jj < 2; ++jj) {
      const int s0 = (2 * g + jj) * 16 + fq * 4;
      float pv[4];
#pragma unroll
      for (int e = 0; e < 4; ++e) {
        const float as = __shfl(av, s0 + e);
        const float D = (s0 + e <= tq) ? __expf(as - Mt) : 0.f;
        pv[e] = s2[jj][e] * D;
      }
      u32x2 o; o[0] = pack2(pv[0], pv[1]); o[1] = pack2(pv[2], pv[3]);
      *(u32x2*)(Ps + tq * 72 + s0) = o;
    }
    __syncthreads();
#pragma unroll
    for (int j = 0; j < 3; ++j) acc3[j] *= cw;
#pragma unroll
    for (int ks = 0; ks < 2; ++ks) {
      const bf16x8 pf = *(const bf16x8*)(Ps + (ti * 16 + fr) * 72 + ks * 32 + fq * 8);
#pragma unroll
      for (int j = 0; j < 3; ++j) {
        const bf16x8 vf = *(const bf16x8*)(VT + (dvt[j] * 16 + fr) * 72 + ks * 32 + fq * 8);
        acc3[j] = MFMA16(vf, pf, acc3[j]);
      }
    }
    {
      const float den = __shfl(acc3[2][0], fr);
      const float inv = rcpf_(fmaxf(fabsf(den), __expf(-(bt + Mt))));
      u16* dst = p.HD + ((size_t)dir * HR + rowof(tq)) * 1024 + h * 256 + vs * 64 + fq * 4;
#pragma unroll
      for (int j = 0; j < 2; ++j) {
        u32x2 o; o[0] = pack2(acc3[j][0] * inv, acc3[j][1] * inv); o[1] = pack2(acc3[j][2] * inv, acc3[j][3] * inv);
        *(u32x2*)(dst + dvt[j] * 16) = o;
      }
    }
    {
      const float dec = __expf(m - M63);
#pragma unroll
      for (int a = 0; a < 5; ++a) { ct[a][0] *= dec; ct[a][1] *= dec; }
#pragma unroll
      for (int ks = 0; ks < 2; ++ks) {
        bf16x8 bk[2];
#pragma unroll
        for (int kk = 0; kk < 2; ++kk) bk[kk] = *(const bf16x8*)(KT + ((2 * w + kk) * 16 + fr) * 72 + ks * 32 + fq * 8);
#pragma unroll
        for (int a = 0; a < 5; ++a) {
          const bf16x8 vf = *(const bf16x8*)(VT + (a * 16 + fr) * 72 + ks * 32 + fq * 8);
          ct[a][0] = MFMA16(bk[0], vf, ct[a][0]);
          ct[a][1] = MFMA16(bk[1], vf, ct[a][1]);
        }
      }
#pragma unroll
      for (int a = 0; a < 5; ++a)
#pragma unroll
        for (int kk = 0; kk < 2; ++kk) {
          u32x2 o; o[0] = pack2(ct[a][kk][0], ct[a][kk][1]); o[1] = pack2(ct[a][kk][2], ct[a][kk][3]);
          *(u32x2*)(CT + (a * 16 + fr) * 264 + (2 * w + kk) * 16 + fq * 4) = o;
        }
    }
    m = bL + M63;
#pragma unroll
    for (int i = 0; i < 2; ++i) { qlo[i] = qlon[i]; qhi[i] = qhin[i]; }
#pragma unroll
    for (int j = 0; j < 8; ++j) { k1[j] = k1n[j]; k2[j] = k2n[j]; vv[j] = vvn[j]; }
    ig = ign; fg = fgn;
    __syncthreads();
  }
}

static __device__ __forceinline__ void mlstm_merge_phase(const Params& p) {
  const int tid = get_tid(), w = tid >> 6, lane = tid & 63;
  for (int lr = blockIdx.x * 8 + w; lr < HR; lr += gridDim.x * 8) {
#pragma unroll
    for (int pass = 0; pass < 2; ++pass) {
      const int c = pass * 512 + lane * 8;
      u32x4 hf = *(const u32x4*)(p.HD + (size_t)lr * 1024 + c);
      u32x4 hbk = *(const u32x4*)(p.HD + ((size_t)HR + lr) * 1024 + c);
      u16* pz = p.P + (size_t)lr * S0 + 8192 + c;
      u32x4 ob = *(const u32x4*)(pz - 1024);
      u32x4 zb = *(const u32x4*)pz;
      float v[8];
      float ss = 0.f;
#pragma unroll
      for (int j = 0; j < 4; ++j) {
        v[2 * j] = (lo2f(hf[j]) + lo2f(hbk[j])) * sigmoidf_(lo2f(ob[j]));
        v[2 * j + 1] = (hi2f(hf[j]) + hi2f(hbk[j])) * sigmoidf_(hi2f(ob[j]));
        ss += v[2 * j] * v[2 * j] + v[2 * j + 1] * v[2 * j + 1];
      }
#pragma unroll
      for (int o = 1; o <= 16; o <<= 1) ss += __shfl_xor(ss, o);
      const float rstd = rsqrtf(ss * (1.f / 256.f) + EPSF);
      const float* hn = p.h_norm_b + c;
      u32x4 o;
#pragma unroll
      for (int j = 0; j < 4; ++j) {
        float y0 = v[2 * j] * rstd * hn[2 * j] * siluf_(lo2f(zb[j]));
        float y1 = v[2 * j + 1] * rstd * hn[2 * j + 1] * siluf_(hi2f(zb[j]));
        o[j] = pack2(y0, y1);
      }
      *(u32x4*)(p.P + (size_t)lr * S0 + 1024 + c) = o;
    }
  }
}

#undef rowof
#define rowof(pp) (rbase + rsgn * (pp))
static __device__ __forceinline__ void gla_unit(const Params& p, int unit) {
  u16* P = p.P;
  u16* Qt = (u16*)smem;
  u16* Kt = Qt + 64 * 136;
  u16* KHT = Kt + 64 * 136;
  u16* VT = KHT + 128 * 72;
  u16* Ps = VT + 128 * 72;
  u16* ST = Ps + 64 * 72;
  float* tot = (float*)(ST + 128 * 136);
  float* sbL = tot + 1024;
  const int tid = get_tid(), w = tid >> 6, lane = tid & 63, fr = lane & 15, fq = lane >> 4;
  const int seg = unit >> 7, ub = unit & 127;
  const int dir = ub & 1, h = (ub >> 1) & 15, bl = ub >> 5;
  const int c0 = seg ? 36 : 0, c1 = seg ? 68 : 36;
  const int ti = w & 3, g2 = w >> 2;
  u16* QC = p.HD + (size_t)ub * 2048 * 128;
  float eruna = 1.f, erunb = 1.f;
  for (int i = tid; i < 128 * 136; i += NT) ST[i] = 0;
  f32x4 st[8];
#pragma unroll
  for (int a = 0; a < 8; ++a) st[a] = zero4();
  const int lfcol = 2048 + dir * 2048 + h * 128;
#define GROW_LOW(cc) (((cc) < 4) ? (HL + bl * 256 + (dir ? 192 - (cc) * 64 : (cc) * 64)) : (bl * 4096 + (dir ? 4032 - ((cc) - 4) * 64 : ((cc) - 4) * 64)))
#undef rowof
#define rowof(pp) (rlow + (dir ? 63 - (pp) : (pp)))
  unsigned toffB[8];
#pragma unroll
  for (int j = 0; j < 8; ++j) toffB[j] = (unsigned)((dir ? 63 - (w * 8 + j) : (w * 8 + j)) * S1 + 2 * lane) * 2u;
#define GLOAD(rl, Q2, L2, V2, WITHQ) do { \
    const char* pq_ = (const char*)(P + (size_t)(rl) * S1 + h * 128); const char* pl_ = (const char*)(P + (size_t)(rl) * S1 + lfcol); \
    const char* pv_ = (const char*)(P + (size_t)(rl) * S1 + 6144 + h * 128); \
    _Pragma("unroll") for (int j = 0; j < 8; ++j) { Q2[j] = (WITHQ) ? *(const unsigned*)(pq_ + toffB[j]) : 0u; \
      L2[j] = *(const unsigned*)(pl_ + toffB[j]); V2[j] = *(const unsigned*)(pv_ + toffB[j]); } } while (0)
  unsigned qE[8], lE[8], vE[8], qO[8], lO[8], vO[8];
  { const int rl0 = GROW_LOW(c0); GLOAD(rl0, qE, lE, vE, seg != 0); const int rl1 = GROW_LOW(c0 + 1); GLOAD(rl1, qO, lO, vO, (c0 + 1) >= 4); }
  __syncthreads();
  auto chunk_body = [&](const int c, unsigned (&q2)[8], unsigned (&l2)[8], unsigned (&v2)[8]) {
    const bool lat = c >= 4;
    const int rlow = GROW_LOW(c);
    float fa[8], fb[8], ca[8], cb[8];
    {
      float ra = 1.f, rb = 1.f;
#pragma unroll
      for (int j = 0; j < 8; ++j) { fa[j] = __expf(lo2f(l2[j])); fb[j] = __expf(hi2f(l2[j])); ra *= fa[j]; rb *= fb[j]; ca[j] = ra; cb[j] = rb; }
      tot[w * 128 + 2 * lane] = ra;
      tot[w * 128 + 2 * lane + 1] = rb;
    }
    __syncthreads();
    float offa = 1.f, offb = 1.f, ELa = 1.f, ELb = 1.f;
#pragma unroll
    for (int g = 0; g < 8; ++g) {
      const float ta = tot[g * 128 + 2 * lane], tb = tot[g * 128 + 2 * lane + 1];
      if (g < w) { offa *= ta; offb *= tb; }
      ELa *= ta; ELb *= tb;
    }
    {
      u32x4 kha, khb, va, vb;
      unsigned kh2[8];
#pragma unroll
      for (int j = 0; j < 8; ++j) {
        const float ea = fmaxf(offa * ca[j], 1e-30f), eb = fmaxf(offb * cb[j], 1e-30f);
        const float ia = __builtin_amdgcn_rcpf(ea), ib = __builtin_amdgcn_rcpf(eb);
        const float kta = (1.f - fa[j]) * ia, ktb = (1.f - fb[j]) * ib;
        const int pp = w * 8 + j;
        const float qa = lo2f(q2[j]) * ea, qb = hi2f(q2[j]) * eb;
        *(unsigned*)(Qt + pp * 136 + 2 * lane) = pack2(qa, qb);
        if (seg) *(unsigned*)(QC + (size_t)((c - 36) * 64 + pp) * 128 + 2 * lane) = pack2(qa * eruna, qb * erunb);
        *(unsigned*)(Kt + pp * 136 + 2 * lane) = pack2(kta, ktb);
        kh2[j] = pack2(kta * ELa, ktb * ELb);
      }
#pragma unroll
      for (int j = 0; j < 4; ++j) {
        kha[j] = (kh2[2 * j] & 0xFFFFu) | (kh2[2 * j + 1] << 16);
        khb[j] = (kh2[2 * j] >> 16) | (kh2[2 * j + 1] & 0xFFFF0000u);
        va[j] = (v2[2 * j] & 0xFFFFu) | (v2[2 * j + 1] << 16);
        vb[j] = (v2[2 * j] >> 16) | (v2[2 * j + 1] & 0xFFFF0000u);
      }
      *(u32x4*)(KHT + (2 * lane) * 72 + w * 8) = kha;
      *(u32x4*)(KHT + (2 * lane + 1) * 72 + w * 8) = khb;
      *(u32x4*)(VT + (2 * lane) * 72 + w * 8) = va;
      *(u32x4*)(VT + (2 * lane + 1) * 72 + w * 8) = vb;
      if (w == 0) { sbL[2 * lane] = ELa; sbL[2 * lane + 1] = ELb; }
      eruna *= ELa; erunb *= ELb;
    }
    if (c + 2 < c1) { const int rl2 = GROW_LOW(c + 2); GLOAD(rl2, q2, l2, v2, (c + 2) >= 4); }
    __syncthreads();
    f32x4 o4[4];
#pragma unroll
    for (int j = 0; j < 4; ++j) o4[j] = zero4();
    const int tq = ti * 16 + fr;
    if (lat) {
      f32x4 s2[2];
      s2[0] = zero4(); s2[1] = zero4();
#pragma unroll
      for (int ks = 0; ks < 4; ++ks) {
        const bf16x8 qf = *(const bf16x8*)(Qt + (ti * 16 + fr) * 136 + ks * 32 + fq * 8);
#pragma unroll
        for (int j = 0; j < 4; ++j) {
          const bf16x8 sf = *(const bf16x8*)(ST + ((4 * g2 + j) * 16 + fr) * 136 + ks * 32 + fq * 8);
          o4[j] = MFMA16(sf, qf, o4[j]);
        }
#pragma unroll
        for (int jj = 0; jj < 2; ++jj) {
          if (2 * g2 + jj <= ti) {
            const bf16x8 kf = *(const bf16x8*)(Kt + ((2 * g2 + jj) * 16 + fr) * 136 + ks * 32 + fq * 8);
            s2[jj] = MFMA16(kf, qf, s2[jj]);
          }
        }
      }
#pragma unroll
      for (int jj = 0; jj < 2; ++jj) {
        const int s0 = (2 * g2 + jj) * 16 + fq * 4;
        u32x2 o;
        o[0] = pack2((s0 + 0 <= tq) ? s2[jj][0] : 0.f, (s0 + 1 <= tq) ? s2[jj][1] : 0.f);
        o[1] = pack2((s0 + 2 <= tq) ? s2[jj][2] : 0.f, (s0 + 3 <= tq) ? s2[jj][3] : 0.f);
        *(u32x2*)(Ps + tq * 72 + s0) = o;
      }
    }
    __syncthreads();
    if (lat) {
#pragma unroll
      for (int ks = 0; ks < 2; ++ks) {
        const bf16x8 pf = *(const bf16x8*)(Ps + (ti * 16 + fr) * 72 + ks * 32 + fq * 8);
#pragma unroll
        for (int j = 0; j < 4; ++j) {
          const bf16x8 vf = *(const bf16x8*)(VT + ((4 * g2 + j) * 16 + fr) * 72 + ks * 32 + fq * 8);
          o4[j] = MFMA16(vf, pf, o4[j]);
        }
      }
      u16* dst = P + (size_t)rowof(tq) * S1 + lfcol + (4 * g2) * 16 + fq * 4;
#pragma unroll
      for (int j = 0; j < 4; ++j) {
        u32x2 o; o[0] = pack2(o4[j][0], o4[j][1]); o[1] = pack2(o4[j][2], o4[j][3]);
        *(u32x2*)(dst + j * 16) = o;
      }
    }
    {
      const f32x4 dk = *(const f32x4*)(sbL + 16 * w + fq * 4);
#pragma unroll
      for (int a = 0; a < 8; ++a) st[a] *= dk;
#pragma unroll
      for (int ks = 0; ks < 2; ++ks) {
        const bf16x8 kf = *(const bf16x8*)(KHT + (w * 16 + fr) * 72 + ks * 32 + fq * 8);
#pragma unroll
        for (int a = 0; a < 8; ++a) {
          const bf16x8 vf = *(const bf16x8*)(VT + (a * 16 + fr) * 72 + ks * 32 + fq * 8);
          st[a] = MFMA16(kf, vf, st[a]);
        }
      }
#pragma unroll
      for (int a = 0; a < 8; ++a) {
        u32x2 o; o[0] = pack2(st[a][0], st[a][1]); o[1] = pack2(st[a][2], st[a][3]);
        *(u32x2*)(ST + (a * 16 + fr) * 136 + 16 * w + fq * 4) = o;
      }
    }
    __syncthreads();
  };
  for (int c = c0; c < c1; c += 2) { chunk_body(c, qE, lE, vE); chunk_body(c + 1, qO, lO, vO); }
  if (!seg) {
    u16* SM = p.H + (size_t)ub * 128 * 128;
    for (int i = tid; i < 128 * 16; i += NT) { const int r = i >> 4, c8 = (i & 15) * 8; *(u32x4*)(SM + r * 128 + c8) = *(const u32x4*)(ST + r * 136 + c8); }
  }
}

static __device__ __forceinline__ void gla_corr_phase(const Params& p) {
  u16* P = p.P;
  u16* SMs = (u16*)smem;
  u16* Qs = SMs + 128 * 136;
  const int tid = get_tid(), w = tid >> 6, lane = tid & 63, fr = lane & 15, fq = lane >> 4;
  const int ti = w & 3, g2 = w >> 2;
  for (int item = get_bid(); item < 256; item += gridDim.x) {
    const int ub = item >> 1, half = item & 1;
    const int dir = ub & 1, h = (ub >> 1) & 15, bl = ub >> 5;
    const int lfcol = 2048 + dir * 2048 + h * 128;
    const u16* SM = p.H + (size_t)ub * 128 * 128;
    const u16* QC = p.HD + (size_t)ub * 2048 * 128;
    __syncthreads();
    for (int i = tid; i < 128 * 16; i += NT) { const int r = i >> 4, c8 = (i & 15) * 8; *(u32x4*)(SMs + r * 136 + c8) = *(const u32x4*)(SM + r * 128 + c8); }
    for (int cc = half * 16; cc < half * 16 + 16; ++cc) {
      __syncthreads();
      for (int i = tid; i < 64 * 16; i += NT) { const int r = i >> 4, c8 = (i & 15) * 8; *(u32x4*)(Qs + r * 136 + c8) = *(const u32x4*)(QC + (size_t)(cc * 64 + r) * 128 + c8); }
      __syncthreads();
      f32x4 o4[4];
#pragma unroll
      for (int j = 0; j < 4; ++j) o4[j] = zero4();
#pragma unroll
      for (int ks = 0; ks < 4; ++ks) {
        const bf16x8 qf = *(const bf16x8*)(Qs + (ti * 16 + fr) * 136 + ks * 32 + fq * 8);
#pragma unroll
        for (int j = 0; j < 4; ++j) {
          const bf16x8 sf = *(const bf16x8*)(SMs + ((4 * g2 + j) * 16 + fr) * 136 + ks * 32 + fq * 8);
          o4[j] = MFMA16(sf, qf, o4[j]);
        }
      }
      const int tq = ti * 16 + fr;
      const int rlow = bl * 4096 + (dir ? 4032 - (32 + cc) * 64 : (32 + cc) * 64);
      const int row = rlow + (dir ? 63 - tq : tq);
      u16* dst = P + (size_t)row * S1 + lfcol + (4 * g2) * 16 + fq * 4;
#pragma unroll
      for (int j = 0; j < 4; ++j) {
        u32x2 v = *(const u32x2*)(dst + j * 16);
        u32x2 o; o[0] = pack2(lo2f(v[0]) + o4[j][0], hi2f(v[0]) + o4[j][1]); o[1] = pack2(lo2f(v[1]) + o4[j][2], hi2f(v[1]) + o4[j][3]);
        *(u32x2*)(dst + j * 16) = o;
      }
    }
  }
}

static __device__ __forceinline__ void gla_merge_phase(const Params& p) {
  const int tid = get_tid(), w = tid >> 6, lane = tid & 63;
  for (int lr = blockIdx.x * 8 + w; lr < HL; lr += gridDim.x * 8) {
#pragma unroll
    for (int pass = 0; pass < 4; ++pass) {
      const int c = pass * 512 + lane * 8;
      u16* pz = p.P + (size_t)lr * S1 + 8192 + c;
      u32x4 of = *(const u32x4*)(pz - 6144);
      u32x4 ob = *(const u32x4*)(pz - 4096);
      u32x4 zb = *(const u32x4*)pz;
      float v[8];
      float ss = 0.f;
#pragma unroll
      for (int j = 0; j < 4; ++j) {
        v[2 * j] = lo2f(of[j]) + lo2f(ob[j]);
        v[2 * j + 1] = hi2f(of[j]) + hi2f(ob[j]);
        ss += v[2 * j] * v[2 * j] + v[2 * j + 1] * v[2 * j + 1];
      }
#pragma unroll
      for (int o = 1; o <= 8; o <<= 1) ss += __shfl_xor(ss, o);
      const float rstd = rsqrtf(ss * (1.f / 128.f) + EPSF);
      const float* hn = p.h_norm_c + c;
      u32x4 o;
#pragma unroll
      for (int j = 0; j < 4; ++j) {
        float y0 = v[2 * j] * rstd * hn[2 * j] * siluf_(lo2f(zb[j]));
        float y1 = v[2 * j + 1] * rstd * hn[2 * j + 1] * siluf_(hi2f(zb[j]));
        o[j] = pack2(y0, y1);
      }
      *(u32x4*)pz = o;
    }
  }
}

#define XB_TMO      128
#define XB_XCNT(j)  (256  + 64 * (j))
#define XB_XSUB(j)  (1280 + 64 * (j))
#define XB_XGEN(j)  (2304 + 64 * (j))
#define XB_TOP      3328
#define XB_TOPGEN   3392
#define XCD_BAR_WORDS 3456
#define XB_SPIN_CAP (1u << 18)
DI unsigned xb_ld(unsigned* p) { return __hip_atomic_load(p, __ATOMIC_RELAXED, __HIP_MEMORY_SCOPE_AGENT); }
DI unsigned xb_add(unsigned* p, unsigned v) { return __hip_atomic_fetch_add(p, v, __ATOMIC_RELAXED, __HIP_MEMORY_SCOPE_AGENT); }
DI unsigned xb_xcc_id() { return (unsigned)__builtin_amdgcn_s_getreg((3 << 11) | 20) & 0xFu; }
#define XB_SPIN(cond, bar) do { unsigned _sp = 0; while (cond) { __builtin_amdgcn_s_sleep(1); \
    if ((++_sp & 255u) == 0u) { if (xb_ld(&(bar)[XB_TMO])) break; if (_sp > XB_SPIN_CAP) { atomicAdd(&(bar)[XB_TMO], 1u); break; } } } } while (0)
struct XcdBarrier { unsigned* bar; unsigned x; volatile LAS unsigned* st; };
DI XcdBarrier xcd_barrier_post(unsigned* bar, volatile LAS unsigned* st) {
  XcdBarrier b; b.bar = bar; b.x = xb_xcc_id(); b.st = st;
  if (threadIdx.x == 0) (void)xb_add(&bar[XB_XCNT(b.x)], 1u);
  return b;
}
DI void xcd_barrier_complete(unsigned* bar, unsigned x, unsigned& nloc, unsigned& nx) {
  const unsigned G = gridDim.x * gridDim.y * gridDim.z;
  unsigned sum, cnt, mine, sp = 0u;
  for (;;) {
    sum = 0u; cnt = 0u; mine = 0u;
#pragma unroll
    for (unsigned j = 0; j < 16; ++j) { const unsigned c = xb_ld(&bar[XB_XCNT(j)]); sum += c; cnt += (c > 0u) ? 1u : 0u; mine = (j == x) ? c : mine; }
    if (sum == G) break;
    __builtin_amdgcn_s_sleep(1);
    if ((++sp & 255u) == 0u) { if (xb_ld(&bar[XB_TMO])) break; if (sp > XB_SPIN_CAP) { atomicAdd(&bar[XB_TMO], 1u); break; } }
  }
  nloc = mine > 0u ? mine : 1u; nx = cnt > 0u ? cnt : 1u;
}
DI void xcd_barrier(const XcdBarrier& b) {
  asm volatile("s_waitcnt vmcnt(0)" ::: "memory");
  __syncthreads();
  if (threadIdx.x == 0) {
    unsigned* bar = b.bar;
    __builtin_amdgcn_s_waitcnt(0);
    unsigned nloc = b.st[0], nx = b.st[1];
    if (nloc == 0u) { xcd_barrier_complete(bar, b.x, nloc, nx); b.st[0] = nloc; b.st[1] = nx; }
    const unsigned old = xb_add(&bar[XB_XSUB(b.x)], 1u);
    const unsigned gen = old / nloc;
    if (old + 1u == (gen + 1u) * nloc) {
      __builtin_amdgcn_fence(__ATOMIC_RELEASE, "agent");
      asm volatile("s_waitcnt vmcnt(0)" ::: "memory");
      const unsigned og = xb_add(&bar[XB_TOP], 1u);
      const unsigned tg = og / nx;
      if (og + 1u == (tg + 1u) * nx) xb_add(&bar[XB_TOPGEN], 1u);
      else XB_SPIN(xb_ld(&bar[XB_TOPGEN]) == tg, bar);
      __builtin_amdgcn_fence(__ATOMIC_ACQUIRE, "agent");
      xb_add(&bar[XB_XGEN(b.x)], 1u);
      asm volatile("s_waitcnt vmcnt(0)" ::: "memory");
    } else {
      XB_SPIN(xb_ld(&bar[XB_XGEN(b.x)]) == gen, bar);
      __builtin_amdgcn_fence(__ATOMIC_ACQUIRE, "agent");
      asm volatile("s_waitcnt vmcnt(0)" ::: "memory");
    }
  }
  __syncthreads();
}

__global__ void __launch_bounds__(512) fwd_megakernel(Params p) {
  cg::grid_group grid = cg::this_grid();
  volatile LAS unsigned* xst = (volatile LAS unsigned*)((LAS unsigned char*)smem + LDS_ST_OFF);
  if (threadIdx.x == 0) { xst[0] = 0u; xst[1] = 0u; xst[2] = 0u; xst[3] = 0u; }
  __syncthreads();
  const XcdBarrier xb = xcd_barrier_post(p.bar, xst);
  prep_phase(p);
  grid.sync();
  for (int hb = 0; hb < 2; ++hb) {
    rmsmod_phase(p, 0, hb);
    xcd_barrier(xb);
    { GemmArgs g{p.H, 1024, p.wt1, 1024, 68, 37}; Epi1 e{p.P, p.G, p.b_gate}; gemm_phase(g, e); }
    xcd_barrier(xb);
    if (blockIdx.x < 128) mlstm_unit(p, blockIdx.x);
    for (;;) {
      __syncthreads();
      if (threadIdx.x == 0) xst[4] = xb_add(&p.bar[3500 + hb], 1u);
      __syncthreads();
      const unsigned u = xst[4];
      if (u >= (unsigned)NA_UNITS) break;
      na_unit(p, (int)u);
    }
    xcd_barrier(xb);
    mlstm_merge_phase(p);
    xcd_barrier(xb);
    { GemmArgs g{p.P, S0, p.wt2, 2048, 68, 4}; EpiRes e{p.x, p.ctx, p.out, p.x1c, p.ada, hb, 0}; gemm_phase(g, e); }
  }
  for (int hb = 0; hb < 2; ++hb) {
    rmsmod_phase(p, 1, hb);
    xcd_barrier(xb);
    { GemmArgs g{p.H, 1024, p.wt3, 1024, 68, 40}; Epi3 e{p.P, p.lb_c}; gemm_phase(g, e); }
    xcd_barrier(xb);
    if (blockIdx.x < 256) gla_unit(p, blockIdx.x);
    xcd_barrier(xb);
    gla_corr_phase(p);
    xcd_barrier(xb);
    gla_merge_phase(p);
    xcd_barrier(xb);
    { GemmArgs g{p.P + 8192, S1, p.wt4, 2048, 64, 4}; EpiRes e{p.x, p.ctx, p.out, p.x1c, p.ada, hb, 1}; gemm_phase(g, e); }
  }
}

extern "C" void kernel_launch(void* const* d_in, const int* in_sizes, int n_in, void* d_out, int out_size,
                              void* d_ws, size_t ws_size, hipStream_t stream) {
  static int grid_blocks = 0;
  if (!grid_blocks) {
    int dev = 0, cus = 0, per_cu = 0;
    (void)hipGetDevice(&dev);
    (void)hipDeviceGetAttribute(&cus, hipDeviceAttributeMultiprocessorCount, dev);
    (void)hipFuncSetAttribute((const void*)fwd_megakernel, hipFuncAttributeMaxDynamicSharedMemorySize, LDS_BYTES);
    (void)hipOccupancyMaxActiveBlocksPerMultiprocessor(&per_cu, (const void*)fwd_megakernel, NT, LDS_BYTES);
    if (per_cu < 1) per_cu = 1;
    grid_blocks = cus * per_cu;
    if (ws_size < WS_END) { fprintf(stderr, "workspace too small: %zu < %zu\n", ws_size, (size_t)WS_END); grid_blocks = -1; }
    if (grid_blocks < 256) { fprintf(stderr, "grid %d < 256 not supported\n", grid_blocks); grid_blocks = -1; }
  }
  if (grid_blocks < 0) return;
  Params p{};
  p.x = (const float*)d_in[0]; p.c = (const float*)d_in[1]; p.ctx = (const float*)d_in[2]; p.c_ctx = (const float*)d_in[3];
  p.norm_w = (const float*)d_in[4]; p.w_ada = (const float*)d_in[5]; p.b_ada = (const float*)d_in[6];
  p.w_in_ab = (const float*)d_in[7]; p.b_gate = (const float*)d_in[8]; p.q_norm = (const float*)d_in[9];
  p.k_norm = (const float*)d_in[10]; p.rpb = (const float*)d_in[11]; p.h_norm_b = (const float*)d_in[12];
  p.w_out_ab = (const float*)d_in[13]; p.w_in_c = (const float*)d_in[14]; p.lb_c = (const float*)d_in[15];
  p.h_norm_c = (const float*)d_in[16]; p.w_out_c = (const float*)d_in[17];
  p.out = (float*)d_out;
  unsigned char* ws = (unsigned char*)d_ws;
  p.wt1 = (u16*)(ws + OFF_WT1); p.wt2 = (u16*)(ws + OFF_WT2); p.wt3 = (u16*)(ws + OFF_WT3); p.wt4 = (u16*)(ws + OFF_WT4);
  p.ada = (float*)(ws + OFF_ADA); p.x1c = (float*)(ws + OFF_X1C); p.G = (float*)(ws + OFF_G);
  p.H = (u16*)(ws + OFF_H); p.HD = (u16*)(ws + OFF_HD); p.P = (u16*)(ws + OFF_P);
  p.bar = (unsigned*)(ws + OFF_BAR);
  (void)hipMemsetAsync(ws + OFF_BAR, 0, 16384, stream);
  void* args[] = {&p};
  hipError_t e = hipLaunchCooperativeKernel((void*)fwd_megakernel, dim3(grid_blocks), dim3(NT), args, LDS_BYTES, stream);
  if (e != hipSuccess) fprintf(stderr, "cooperative launch failed: %s (grid %d)\n", hipGetErrorString(e), grid_blocks);
}
```

```cpp
#include <hip/hip_runtime.h>
#include <hip/hip_cooperative_groups.h>
#include <cstdio>
namespace cg = cooperative_groups;

typedef unsigned short u16;
typedef __attribute__((ext_vector_type(8))) short bf16x8;
typedef __attribute__((ext_vector_type(4))) float f32x4;
typedef __attribute__((ext_vector_type(4))) unsigned int u32x4;
typedef __attribute__((ext_vector_type(2))) unsigned int u32x2;
typedef __attribute__((ext_vector_type(2))) __bf16 bf2_t;

#define DI __device__ __forceinline__
#define MFMA16(a, b, c) __builtin_amdgcn_mfma_f32_16x16x32_bf16((a), (b), (c), 0, 0, 0)

constexpr int NT = 512;
constexpr int LDS_ST_OFF = 159744;
constexpr int LDS_BYTES = LDS_ST_OFF + 64;
constexpr int HL = 16384;
constexpr int HR = 17408;
constexpr int S0 = 9216;
constexpr int S1 = 10240;
constexpr float EPSF = 1e-6f;

constexpr size_t OFF_WT1 = 0;
constexpr size_t OFF_WT2 = OFF_WT1 + (size_t)9472 * 1024 * 2;
constexpr size_t OFF_WT3 = OFF_WT2 + (size_t)1024 * 2048 * 2;
constexpr size_t OFF_WT4 = OFF_WT3 + (size_t)10240 * 1024 * 2;
constexpr size_t OFF_ADA = OFF_WT4 + (size_t)1024 * 2048 * 2;
constexpr size_t OFF_X1C = OFF_ADA + (size_t)2 * 9 * 3072 * 4;
constexpr size_t OFF_G = OFF_X1C + (size_t)2048 * 1024 * 4;
constexpr size_t OFF_H = OFF_G + (size_t)HR * 16 * 4;
constexpr size_t OFF_HD = OFF_H + (size_t)HR * 1024 * 2;
constexpr size_t OFF_P = OFF_HD + (size_t)2 * HR * 1024 * 2;
constexpr size_t OFF_BAR = OFF_P + (size_t)HR * 10240 * 2;
constexpr size_t WS_END = OFF_BAR + 16384;

struct Params {
  const float* x; const float* c; const float* ctx; const float* c_ctx; const float* norm_w; const float* w_ada;
  const float* b_ada; const float* w_in_ab; const float* b_gate; const float* q_norm; const float* k_norm;
  const float* rpb; const float* h_norm_b; const float* w_out_ab; const float* w_in_c; const float* lb_c;
  const float* h_norm_c; const float* w_out_c;
  float* out;
  u16* wt1; u16* wt2; u16* wt3; u16* wt4;
  float* ada; float* x1c; float* G; u16* H; u16* HD; u16* P;
  unsigned* bar;
};

extern __shared__ __attribute__((aligned(16))) unsigned char smem[];

DI u16 f2bf(float f) { __bf16 h = (__bf16)f; return __builtin_bit_cast(u16, h); }
DI unsigned pack2(float a, float b) { bf2_t v; v[0] = (__bf16)a; v[1] = (__bf16)b; return __builtin_bit_cast(unsigned, v); }
DI float bf2f(u16 h) { return __uint_as_float(((unsigned)h) << 16); }
DI float lo2f(unsigned u) { return __uint_as_float(u << 16); }
DI float hi2f(unsigned u) { return __uint_as_float(u & 0xFFFF0000u); }
DI float fastlogf_(float x) { return __builtin_amdgcn_logf(x) * 0.69314718f; }
DI float rcpf_(float x) { return __builtin_amdgcn_rcpf(x); }
DI float sigmoidf_(float v) { return rcpf_(1.f + __expf(-v)); }
DI float siluf_(float v) { return v * rcpf_(1.f + __expf(-v)); }
DI f32x4 zero4() { f32x4 z = {0.f, 0.f, 0.f, 0.f}; return z; }
template <int CTRL, int ROWMASK> DI float dpp_f(float oldv, float src) {
  return __builtin_bit_cast(float, __builtin_amdgcn_update_dpp(__builtin_bit_cast(int, oldv), __builtin_bit_cast(int, src), CTRL, ROWMASK, 0xf, false));
}
DI float wave_scan_add(float v) {
  v += dpp_f<0x111, 0xf>(0.f, v);
  v += dpp_f<0x112, 0xf>(0.f, v);
  v += dpp_f<0x114, 0xf>(0.f, v);
  v += dpp_f<0x118, 0xf>(0.f, v);
  v += dpp_f<0x142, 0xa>(0.f, v);
  v += dpp_f<0x143, 0xc>(0.f, v);
  return v;
}
DI float wave_scan_max(float v) {
  v = fmaxf(v, dpp_f<0x111, 0xf>(-INFINITY, v));
  v = fmaxf(v, dpp_f<0x112, 0xf>(-INFINITY, v));
  v = fmaxf(v, dpp_f<0x114, 0xf>(-INFINITY, v));
  v = fmaxf(v, dpp_f<0x118, 0xf>(-INFINITY, v));
  v = fmaxf(v, dpp_f<0x142, 0xa>(-INFINITY, v));
  v = fmaxf(v, dpp_f<0x143, 0xc>(-INFINITY, v));
  return v;
}
DI int get_tid() { int t = threadIdx.x; asm volatile("" : "+v"(t)); return t; }
DI int get_bid() { int b = blockIdx.x; asm volatile("" : "+s"(b)); return b; }

static __device__ __forceinline__ void ada_item(const Params& p, int item) {
  const int tid = get_tid();
  float* sc = (float*)smem;
  float* red = sc + 9216;
  const int l = item / 48, col0 = (item % 48) * 64;
  for (int i = tid; i < 9216; i += NT) {
    int r = i >> 10, k = i & 1023;
    float c = (r < 8) ? p.c[r * 1024 + k] : p.c_ctx[k];
    sc[i] = siluf_(c);
  }
  __syncthreads();
  const int w = tid >> 6, lane = tid & 63;
  float acc[9];
#pragma unroll
  for (int r = 0; r < 9; ++r) acc[r] = 0.f;
  const float* W = p.w_ada + (size_t)l * 1024 * 3072 + col0 + lane;
#pragma unroll 4
  for (int k = w * 128; k < w * 128 + 128; ++k) {
    float wv = W[(size_t)k * 3072];
#pragma unroll
    for (int r = 0; r < 9; ++r) acc[r] += sc[r * 1024 + k] * wv;
  }
#pragma unroll
  for (int r = 0; r < 9; ++r) red[(w * 9 + r) * 64 + lane] = acc[r];
  __syncthreads();
  for (int i = tid; i < 576; i += NT) {
    int r = i >> 6, cl = i & 63;
    float s = p.b_ada[l * 3072 + col0 + cl];
#pragma unroll
    for (int w2 = 0; w2 < 8; ++w2) s += red[(w2 * 9 + r) * 64 + cl];
    p.ada[(l * 9 + r) * 3072 + col0 + cl] = s;
  }
  __syncthreads();
}

static __device__ __forceinline__ void transpose_tile(const float* W, u16* Wt, int K, int N, int tn, int tk, int s_lo, int s_hi, int p_lo = 0, int p_hi = 0) {
  const int tid = get_tid();
  u16* T = (u16*)smem;
  const int n0 = tn * 64, k0 = tk * 128;
#pragma unroll
  for (int i = 0; i < 4; ++i) {
    int idx = tid + NT * i;
    int kr = idx >> 4, c4 = idx & 15;
    int n = n0 + c4 * 4;
    float4 v = make_float4(0.f, 0.f, 0.f, 0.f);
    if (n >= p_lo && n < p_hi) {
      const int sb = (n & ~127) + ((n & 127) >> 1);
      const float2 a = *(const float2*)(W + (size_t)(k0 + kr) * N + sb);
      const float2 b = *(const float2*)(W + (size_t)(k0 + kr) * N + sb + 64);
      v = make_float4(a.x, b.x, a.y, b.y);
    } else if (n < N) v = *(const float4*)(W + (size_t)(k0 + kr) * N + n);
    if (n >= s_lo && n < s_hi) { v.x *= 0.0625f; v.y *= 0.0625f; v.z *= 0.0625f; v.w *= 0.0625f; }
    T[(c4 * 4 + 0) * 136 + kr] = f2bf(v.x);
    T[(c4 * 4 + 1) * 136 + kr] = f2bf(v.y);
    T[(c4 * 4 + 2) * 136 + kr] = f2bf(v.z);
    T[(c4 * 4 + 3) * 136 + kr] = f2bf(v.w);
  }
  __syncthreads();
#pragma unroll
  for (int i = 0; i < 2; ++i) {
    int idx = tid + NT * i;
    int n = idx >> 4, ck = idx & 15;
    u32x4 val = *(const u32x4*)(T + n * 136 + ck * 8);
    *(u32x4*)(Wt + (size_t)(n0 + n) * K + k0 + ck * 8) = val;
  }
  __syncthreads();
}

static __device__ __forceinline__ void prep_phase(const Params& p) {
  const int n_items = 96 + 1184 + 1280 + 256 + 256;
  for (int item = blockIdx.x; item < n_items; item += gridDim.x) {
    if (item < 96) { ada_item(p, item); continue; }
    int t = item - 96;
    if (t < 1184) { transpose_tile(p.w_in_ab, p.wt1, 1024, 9232, t >> 3, t & 7, 5120, 6144, 4096, 6144); continue; }
    t -= 1184;
    if (t < 1280) { transpose_tile(p.w_in_c, p.wt3, 1024, 10240, t >> 3, t & 7, 0, 0); continue; }
    t -= 1280;
    if (t < 256) { transpose_tile(p.w_out_ab, p.wt2, 2048, 1024, t >> 4, t & 15, 0, 0); continue; }
    t -= 256;
    transpose_tile(p.w_out_c, p.wt4, 2048, 1024, t >> 4, t & 15, 0, 0);
  }
}

static __device__ __forceinline__ void rmsmod_phase(const Params& p, int layer, int hb) {
  const int tid = get_tid(), w = tid >> 6, lane = tid & 63;
  for (int lr = blockIdx.x * 8 + w; lr < HR; lr += gridDim.x * 8) {
    const float* src; int r;
    if (lr < HL) {
      size_t grow = (size_t)hb * HL + lr;
      src = (layer == 0 ? p.x : (const float*)p.out) + grow * 1024;
      r = hb * 4 + (lr >> 12);
    } else {
      size_t g = (size_t)hb * 1024 + (lr - HL);
      src = (layer == 0 ? p.ctx : (const float*)p.x1c) + g * 1024;
      r = 8;
    }
    float4 v[4];
    float ss = 0.f;
#pragma unroll
    for (int i = 0; i < 4; ++i) {
      v[i] = *(const float4*)(src + lane * 4 + 256 * i);
      ss += v[i].x * v[i].x + v[i].y * v[i].y + v[i].z * v[i].z + v[i].w * v[i].w;
    }
#pragma unroll
    for (int o = 32; o >= 1; o >>= 1) ss += __shfl_xor(ss, o);
    const float rstd = rsqrtf(ss * (1.f / 1024.f) + EPSF);
    const float* ada = p.ada + (layer * 9 + r) * 3072;
    const float* nw = p.norm_w + layer * 1024;
#pragma unroll
    for (int i = 0; i < 4; ++i) {
      int col = lane * 4 + 256 * i;
      float4 sh = *(const float4*)(ada + col);
      float4 sc = *(const float4*)(ada + 1024 + col);
      float4 nv = *(const float4*)(nw + col);
      float o0 = v[i].x * rstd * nv.x * (1.f + sc.x) + sh.x;
      float o1 = v[i].y * rstd * nv.y * (1.f + sc.y) + sh.y;
      float o2 = v[i].z * rstd * nv.z * (1.f + sc.z) + sh.z;
      float o3 = v[i].w * rstd * nv.w * (1.f + sc.w) + sh.w;
      u32x2 pk; pk[0] = pack2(o0, o1); pk[1] = pack2(o2, o3);
      *(u32x2*)(p.H + (size_t)lr * 1024 + col) = pk;
    }
  }
}

#define LAS __attribute__((address_space(3)))
constexpr int G_HALF = 128, G_HTB = 128 * 64 * 2;
DI int lds_byte(int r, int c) { const int st = (r >> 4) * 2 + (c >> 5), rr = r & 15, cc = c & 31, ob = rr * 64 + cc * 2; return st * 1024 + (ob ^ (((ob >> 9) & 1) << 5)); }
DI void stage_rc(int b, int& R, int& C) { const int st = b / 1024, sb = b % 1024, swz = sb ^ (((sb >> 9) & 1) << 5); R = (st >> 1) * 16 + swz / 64; C = (st & 1) * 32 + (swz % 64) / 2; }
DI int perm32(int rho) { const int n = rho >> 4, i = rho & 15; return 8 * (i >> 2) + 4 * n + (i & 3); }
struct Unit { int pm, pn; };
struct Order {
  int nM, nN, nwg, G, c;
  DI void init(int nM_, int nN_, int G_, int c_) { nM = nM_; nN = nN_; nwg = nM * nN; G = G_; c = c_; }
  DI bool next(int i, Unit& u) const {
    const long L = (long)i * G + c; if (L >= nwg) return false;
    int wgid = (int)L; { const int q = nwg / 8, r = nwg % 8, xcd = wgid % 8, off = wgid / 8; wgid = (xcd < r ? xcd * (q + 1) : r * (q + 1) + (xcd - r) * q) + off; }
    const int nig = 4 * nN, gid = wgid / nig, fm = gid * 4, gsz = (nM - fm) < 4 ? (nM - fm) : 4;
    u.pm = fm + ((wgid % nig) % gsz); u.pn = (wgid % nig) / gsz; return true;
  }
};
struct GemmArgs { const u16* A; int lda; const u16* Bt; int K; int nM, nN; };

struct Epi1 {
  static constexpr bool PERM = true;
  u16* P; float* G; const float* b_gate;
  DI void operator()(const f32x4 (&acc)[2][2][4][2], const Unit& u, int wr, int wc, int fr, int fq) const {
    const int row0 = u.pm * 256 + wr * 64 + fr;
    if (u.pn >= 16 && u.pn < 24 && u.pm * 256 < HL) {
      const int col0 = u.pn * 256 + wc * 32 + 8 * fq;
      int frl = fr, fql = fq;
      asm volatile("" : "+v"(frl), "+v"(fql));
      float fr4[4];
#pragma unroll
      for (int jj = 0; jj < 4; ++jj) fr4[jj] = __builtin_amdgcn_exp2f(-(float)(wc * 16 + 4 * fql + jj) * (13.287712379549449f / 64.f));
#pragma unroll
      for (int ai = 0; ai < 2; ++ai) {
        const float pos = (float)(((row0 + ai * 128) & 4095) >> 6);
        float cs[4], sn[4];
#pragma unroll
        for (int jj = 0; jj < 4; ++jj) { const float ang = pos * fr4[jj]; cs[jj] = __cosf(ang); sn[jj] = __sinf(ang); }
#pragma unroll
        for (int m = 0; m < 4; ++m) {
          const f32x4 v0 = acc[ai][0][m][0], v1 = acc[ai][0][m][1];
          u32x4 ov;
          ov[0] = pack2(v0[0] * cs[0] - v0[1] * sn[0], v0[1] * cs[0] + v0[0] * sn[0]);
          ov[1] = pack2(v0[2] * cs[1] - v0[3] * sn[1], v0[3] * cs[1] + v0[2] * sn[1]);
          ov[2] = pack2(v1[0] * cs[2] - v1[1] * sn[2], v1[1] * cs[2] + v1[0] * sn[2]);
          ov[3] = pack2(v1[2] * cs[3] - v1[3] * sn[3], v1[3] * cs[3] + v1[2] * sn[3]);
          *(u32x4*)(P + (size_t)(row0 + ai * 128 + m * 16) * S0 + col0) = ov;
        }
        __builtin_amdgcn_sched_barrier(0);
      }
#pragma unroll
      for (int m = 0; m < 4; ++m) {
        const float pos = (float)(frl + 16 * m);
        float cs[4], sn[4];
#pragma unroll
        for (int jj = 0; jj < 4; ++jj) { const float ang = pos * fr4[jj]; cs[jj] = __cosf(ang); sn[jj] = __sinf(ang); }
#pragma unroll
        for (int ai = 0; ai < 2; ++ai) {
          const f32x4 v0 = acc[ai][1][m][0], v1 = acc[ai][1][m][1];
          u32x4 ov;
          ov[0] = pack2(v0[0] * cs[0] - v0[1] * sn[0], v0[1] * cs[0] + v0[0] * sn[0]);
          ov[1] = pack2(v0[2] * cs[1] - v0[3] * sn[1], v0[3] * cs[1] + v0[2] * sn[1]);
          ov[2] = pack2(v1[0] * cs[2] - v1[1] * sn[2], v1[1] * cs[2] + v1[0] * sn[2]);
          ov[3] = pack2(v1[2] * cs[3] - v1[3] * sn[3], v1[3] * cs[3] + v1[2] * sn[3]);
          *(u32x4*)(P + (size_t)(row0 + ai * 128 + m * 16) * S0 + col0 + 128) = ov;
        }
        __builtin_amdgcn_sched_barrier(0);
      }
    } else if (u.pn < 36) {
      const int col0 = u.pn * 256 + wc * 32 + 8 * fq;
#pragma unroll
      for (int ai = 0; ai < 2; ++ai)
#pragma unroll
        for (int m = 0; m < 4; ++m) {
          u16* rowp = P + (size_t)(row0 + ai * 128 + m * 16) * S0 + col0;
#pragma unroll
          for (int bj = 0; bj < 2; ++bj) {
            const f32x4 v0 = acc[ai][bj][m][0], v1 = acc[ai][bj][m][1];
            u32x4 o; o[0] = pack2(v0[0], v0[1]); o[1] = pack2(v0[2], v0[3]); o[2] = pack2(v1[0], v1[1]); o[3] = pack2(v1[2], v1[3]);
            *(u32x4*)(rowp + bj * 128) = o;
          }
        }
    } else if (wc == 0 && fq < 2) {
      const f32x4 b0 = *(const f32x4*)(b_gate + 8 * fq), b1 = *(const f32x4*)(b_gate + 8 * fq + 4);
#pragma unroll
      for (int ai = 0; ai < 2; ++ai)
#pragma unroll
        for (int m = 0; m < 4; ++m) {
          float* g = G + (size_t)(row0 + ai * 128 + m * 16) * 16 + 8 * fq;
          *(f32x4*)g = acc[ai][0][m][0] + b0;
          *(f32x4*)(g + 4) = acc[ai][0][m][1] + b1;
        }
    }
  }
};
struct Epi3 {
  static constexpr bool PERM = true;
  u16* P; const float* lb_c;
  DI void operator()(const f32x4 (&acc)[2][2][4][2], const Unit& u, int wr, int wc, int fr, int fq) const {
    const int row0 = u.pm * 256 + wr * 64 + fr;
    const int col0 = u.pn * 256 + wc * 32 + 8 * fq;
    const int type = u.pn >> 3;
    float lbv[2][8];
    if (type == 1 || type == 2) {
#pragma unroll
      for (int bj = 0; bj < 2; ++bj)
#pragma unroll
        for (int j = 0; j < 8; ++j) { const int cc = (col0 + bj * 128 + j) & 2047; lbv[bj][j] = rcpf_(1.f + __expf(lb_c[cc] - lb_c[2048 + cc])); }
    } else {
#pragma unroll
      for (int bj = 0; bj < 2; ++bj)
#pragma unroll
        for (int j = 0; j < 8; ++j) lbv[bj][j] = 0.f;
    }
#pragma unroll
    for (int ai = 0; ai < 2; ++ai)
#pragma unroll
      for (int m = 0; m < 4; ++m) {
        u16* rowp = P + (size_t)(row0 + ai * 128 + m * 16) * S1 + col0;
#pragma unroll
        for (int bj = 0; bj < 2; ++bj) {
          float v[8];
#pragma unroll
          for (int j = 0; j < 4; ++j) { v[j] = acc[ai][bj][m][0][j]; v[4 + j] = acc[ai][bj][m][1][j]; }
          if (type == 0) {
#pragma unroll
            for (int j = 0; j < 8; ++j) v[j] = siluf_(v[j]);
          } else if (type == 1 || type == 2) {
#pragma unroll
            for (int j = 0; j < 8; ++j) v[j] = fastlogf_(lbv[bj][j] + (1.f - lbv[bj][j]) * sigmoidf_(v[j]));
          }
          u32x4 o; o[0] = pack2(v[0], v[1]); o[1] = pack2(v[2], v[3]); o[2] = pack2(v[4], v[5]); o[3] = pack2(v[6], v[7]);
          *(u32x4*)(rowp + bj * 128) = o;
        }
      }
  }
};
struct EpiRes {
  static constexpr bool PERM = false;
  const float* x; const float* ctx; float* out; float* x1c; const float* ada; int hb; int layer;
  DI void operator()(const f32x4 (&acc)[2][2][4][2], const Unit& u, int wr, int wc, int fr, int fq) const {
    const int lr0 = u.pm * 256;
    const float* xin; float* dst; const float* gate;
    if (lr0 < HL) {
      const size_t g0 = ((size_t)hb * HL + lr0) * 1024;
      xin = (layer == 0 ? x : (const float*)out) + g0; dst = out + g0;
      gate = ada + (layer * 9 + hb * 4 + (lr0 >> 12)) * 3072 + 2048;
    } else {
      const size_t g0 = ((size_t)hb * 1024 + (lr0 - HL)) * 1024;
      xin = ctx + g0; dst = x1c + g0;
      gate = ada + (layer * 9 + 8) * 3072 + 2048;
    }
    const int col0 = u.pn * 256 + wc * 32 + 4 * fq;
    f32x4 gv[2][2];
#pragma unroll
    for (int bj = 0; bj < 2; ++bj)
#pragma unroll
      for (int n = 0; n < 2; ++n) gv[bj][n] = *(const f32x4*)(gate + col0 + bj * 128 + n * 16);
#pragma unroll
    for (int ai = 0; ai < 2; ++ai)
#pragma unroll
      for (int m = 0; m < 4; ++m) {
        const size_t off = (size_t)(wr * 64 + fr + ai * 128 + m * 16) * 1024 + col0;
#pragma unroll
        for (int bj = 0; bj < 2; ++bj)
#pragma unroll
          for (int n = 0; n < 2; ++n) {
            const f32x4 xv = *(const f32x4*)(xin + off + bj * 128 + n * 16);
            *(f32x4*)(dst + off + bj * 128 + n * 16) = xv + gv[bj][n] * acc[ai][bj][m][n];
          }
      }
  }
};

template <class Epi>
static __device__ __forceinline__ void gemm_phase(const GemmArgs g, const Epi& E) {
  LAS unsigned char* lds = (LAS unsigned char*)smem;
  const int tid = get_tid(), wid = __builtin_amdgcn_readfirstlane(tid >> 6), lane = tid & 63, wr = wid >> 2, wc = wid & 3, fr = lane & 15, fq = lane >> 4;
  const int K = g.K, nt = K / 64;
  Order S; S.init(g.nM, g.nN, gridDim.x, get_bid());
  unsigned voffA[2], voffB[2];
#pragma unroll
  for (int i = 0; i < 2; ++i) {
    int R, C; stage_rc(tid * 16 + i * 8192, R, C);
    const int Rb = Epi::PERM ? ((R & ~31) + perm32(R & 31)) : R;
    voffA[i] = (unsigned)(R * g.lda + C) * 2u; voffB[i] = (unsigned)(Rb * K + C) * 2u;
  }
  const size_t kstep = 128;
  const size_t hstepA = (size_t)G_HALF * g.lda * 2, hstepB = (size_t)G_HALF * K * 2;
  const size_t tstepA = 2 * hstepA, tstepB = 2 * hstepB;
  const unsigned ldsw = (unsigned)wid * 1024u;
  const int aoff = lds_byte(wr * 64 + fr, fq * 8), boff = lds_byte(wc * 32 + fr, fq * 8);
#define PG8_SA(b, h) (((b) * 2 + (h)) * G_HTB)
#define PG8_SB(b, h) ((4 + (b) * 2 + (h)) * G_HTB)
#define PG8_STAGE(bufoff, gbase, voff) do { _Pragma("unroll") for (int _i = 0; _i < 2; ++_i) \
    __builtin_amdgcn_global_load_lds((const unsigned*)((const char*)(gbase) + (voff)[_i]), (LAS unsigned*)(lds + (bufoff) + ldsw + _i * 8192), 16, 0, 0); } while (0)
#define PG8_LDA(dst, b, h) do { _Pragma("unroll") for (int m = 0; m < 4; ++m) _Pragma("unroll") for (int k = 0; k < 2; ++k) dst[m][k] = *(const LAS bf16x8*)(lds + PG8_SA(b, h) + aoff + m * 2048 + k * 1024); } while (0)
#define PG8_LDB(dst, b, h) do { _Pragma("unroll") for (int n = 0; n < 2; ++n) _Pragma("unroll") for (int k = 0; k < 2; ++k) dst[n][k] = *(const LAS bf16x8*)(lds + PG8_SB(b, h) + boff + n * 2048 + k * 1024); } while (0)
#define PG8_MMA(ai, bj, At, Bt) do { __builtin_amdgcn_s_setprio(1); _Pragma("unroll") for (int m = 0; m < 4; ++m) _Pragma("unroll") for (int n = 0; n < 2; ++n) _Pragma("unroll") for (int k = 0; k < 2; ++k) \
    acc[ai][bj][m][n] = __builtin_amdgcn_mfma_f32_16x16x32_bf16(Bt[n][k], At[m][k], acc[ai][bj][m][n], 0, 0, 0); __builtin_amdgcn_s_setprio(0); } while (0)
#define PG8_WAIT_V(n) asm volatile("s_waitcnt vmcnt(" #n ")" ::: "memory")
#define PG8_WAIT_L(n) asm volatile("s_waitcnt lgkmcnt(" #n ")" ::: "memory")
#define PG8_BAR __builtin_amdgcn_s_barrier()
#define PG8_SCHED __builtin_amdgcn_sched_barrier(0)
  Unit cur, nxt; int ui = 0;
  if (S.next(0, cur)) {
  f32x4 acc[2][2][4][2];
#pragma unroll
  for (int a = 0; a < 2; ++a)
#pragma unroll
    for (int b = 0; b < 2; ++b)
#pragma unroll
      for (int m = 0; m < 4; ++m)
#pragma unroll
        for (int n = 0; n < 2; ++n) acc[a][b][m][n] = zero4();
  bf16x8 At[4][2], B0[2][2], B1[2][2];
  const char* cA = (const char*)g.A + (size_t)cur.pm * tstepA; const char* cB = (const char*)g.Bt + (size_t)cur.pn * tstepB;
  PG8_STAGE(PG8_SB(0, 0), cB, voffB); PG8_STAGE(PG8_SA(0, 0), cA, voffA); PG8_STAGE(PG8_SB(0, 1), cB + hstepB, voffB); PG8_STAGE(PG8_SA(0, 1), cA + hstepA, voffA);
  if (wr == 1) PG8_BAR;
  PG8_WAIT_V(4); PG8_BAR;
  PG8_STAGE(PG8_SB(1, 0), cB + kstep, voffB); PG8_STAGE(PG8_SA(1, 0), cA + kstep, voffA); PG8_STAGE(PG8_SB(1, 1), cB + hstepB + kstep, voffB);
  PG8_WAIT_V(6); PG8_BAR;
  for (;;) {
    const bool has_next = S.next(ui + 1, nxt);
    const char* nA = has_next ? (const char*)g.A + (size_t)nxt.pm * tstepA : cA; const char* nB = has_next ? (const char*)g.Bt + (size_t)nxt.pn * tstepB : cB;
    for (int t = 0; t < nt; t += 2) {
      const bool last = (t == nt - 2);
      const char* a1 = cA + (size_t)(t + 1) * kstep;
      const char* a2 = last ? nA : cA + (size_t)(t + 2) * kstep; const char* b2 = last ? nB : cB + (size_t)(t + 2) * kstep;
      const char* a3 = a2 + kstep; const char* b3 = b2 + kstep;
      PG8_LDB(B0, 0, 0); PG8_SCHED; PG8_LDA(At, 0, 0); PG8_STAGE(PG8_SA(1, 1), a1 + hstepA, voffA);
      PG8_WAIT_L(8); PG8_BAR; PG8_WAIT_L(0); PG8_MMA(0, 0, At, B0); PG8_BAR; PG8_SCHED;
      PG8_LDB(B1, 0, 1); PG8_STAGE(PG8_SB(0, 0), b2, voffB);
      PG8_BAR; PG8_WAIT_L(0); PG8_MMA(0, 1, At, B1); PG8_BAR;
      PG8_LDA(At, 0, 1); PG8_STAGE(PG8_SA(0, 0), a2, voffA);
      PG8_BAR; PG8_WAIT_L(0); PG8_MMA(1, 0, At, B0); PG8_BAR; PG8_SCHED;
      PG8_STAGE(PG8_SB(0, 1), b2 + hstepB, voffB);
      PG8_WAIT_V(6); PG8_BAR; PG8_MMA(1, 1, At, B1); PG8_BAR;
      PG8_LDB(B0, 1, 0); PG8_SCHED; PG8_LDA(At, 1, 0); PG8_STAGE(PG8_SA(0, 1), a2 + hstepA, voffA);
      PG8_WAIT_L(8); PG8_BAR; PG8_WAIT_L(0); PG8_MMA(0, 0, At, B0); PG8_BAR; PG8_SCHED;
      PG8_LDB(B1, 1, 1); PG8_STAGE(PG8_SB(1, 0), b3, voffB);
      PG8_BAR; PG8_WAIT_L(0); PG8_MMA(0, 1, At, B1); PG8_BAR;
      PG8_LDA(At, 1, 1); PG8_STAGE(PG8_SA(1, 0), a3, voffA);
      PG8_BAR; PG8_WAIT_L(0); PG8_MMA(1, 0, At, B0); PG8_BAR; PG8_SCHED;
      PG8_STAGE(PG8_SB(1, 1), b3 + hstepB, voffB);
      PG8_WAIT_V(6); PG8_BAR; PG8_MMA(1, 1, At, B1); PG8_BAR;
    }
    E(acc, cur, wr, wc, fr, fq);
    if (!has_next) break;
#pragma unroll
    for (int a = 0; a < 2; ++a)
#pragma unroll
      for (int b = 0; b < 2; ++b)
#pragma unroll
        for (int m = 0; m < 4; ++m)
#pragma unroll
          for (int n = 0; n < 2; ++n) acc[a][b][m][n] = zero4();
    cur = nxt; cA = nA; cB = nB; ++ui;
  }
  PG8_WAIT_V(0);
  if (wr == 0) PG8_BAR;
  PG8_BAR;
  }
#undef PG8_SA
#undef PG8_SB
#undef PG8_STAGE
#undef PG8_LDA
#undef PG8_LDB
#undef PG8_MMA
#undef PG8_WAIT_V
#undef PG8_WAIT_L
#undef PG8_BAR
#undef PG8_SCHED
}

constexpr int NA_UNITS = 1024 + 64;
static __device__ __forceinline__ void na_unit(const Params& p, int unit) {
  u16* P = p.P;
  u16* Ks = (u16*)smem;
  u16* Vt = Ks + 2 * 4608;
  float* rpb_s = (float*)(Vt + 2 * 4352);
  const int tid = get_tid(), w = tid >> 6, lane = tid & 63, fr = lane & 15, fq = lane >> 4;
  const bool isctx = unit >= 1024;
  int bl, h, rq = 0;
  if (!isctx) { bl = unit >> 8; h = (unit >> 4) & 15; rq = unit & 15; }
  else { const int u = unit - 1024; bl = u >> 4; h = u & 15; }
  const int col = (w & 3) * 16 + fr;
  int rr[2], lrq[2], r0s[2];
#pragma unroll
  for (int sx = 0; sx < 2; ++sx) {
    rr[sx] = 4 * rq + (w >> 2) + 2 * sx;
    lrq[sx] = isctx ? (HL + bl * 256 + sx * 128 + w * 16 + fr) : (bl * 4096 + rr[sx] * 64 + col);
    r0s[sx] = min(max(rr[sx] - 4, 0), 56);
  }
  const int r0a = min(max(4 * rq - 4, 0), 56), r0b = min(max(4 * rq - 1, 0), 56);
  const int nlat = isctx ? 0 : (r0b + 8 - r0a);
  const int nt = nlat + 4;
  if (!isctx) for (int i = tid; i < 465; i += NT) rpb_s[i] = p.rpb[h * 465 + i];
  bf16x8 qf[2][2];
#pragma unroll
  for (int sx = 0; sx < 2; ++sx) {
    u32x4 qr[2];
    float qv[2][8];
    float ss = 0.f;
#pragma unroll
    for (int ks = 0; ks < 2; ++ks) {
      qr[ks] = *(const u32x4*)(P + (size_t)lrq[sx] * S0 + h * 64 + ks * 32 + fq * 8);
#pragma unroll
      for (int j = 0; j < 4; ++j) { qv[ks][2 * j] = lo2f(qr[ks][j]); qv[ks][2 * j + 1] = hi2f(qr[ks][j]); }
#pragma unroll
      for (int j = 0; j < 8; ++j) ss += qv[ks][j] * qv[ks][j];
    }
    ss += __shfl_xor(ss, 16);
    ss += __shfl_xor(ss, 32);
    const float rstd = rsqrtf(ss * (1.f / 64.f) + EPSF) * 0.125f;
#pragma unroll
    for (int ks = 0; ks < 2; ++ks) {
      const float* qn = p.q_norm + ks * 32 + fq * 8;
      u32x4 o;
#pragma unroll
      for (int j = 0; j < 4; ++j) o[j] = pack2(qv[ks][2 * j] * rstd * qn[2 * j], qv[ks][2 * j + 1] * rstd * qn[2 * j + 1]);
      qf[sx][ks] = __builtin_bit_cast(bf16x8, o);
    }
  }
  f32x4 ot[2][4];
  float mrun[2], lrun[2];
#pragma unroll
  for (int sx = 0; sx < 2; ++sx) {
    mrun[sx] = -INFINITY; lrun[sx] = 0.f;
#pragma unroll
    for (int d = 0; d < 4; ++d) ot[sx][d] = zero4();
  }
  const int lkey = tid >> 3, lc = tid & 7;
  u32x4 kreg, vreg;
  auto gload = [&](int i) {
    int lrk = (i < nlat) ? (bl * 4096 + (r0a + i) * 64 + lkey) : (HL + bl * 256 + (i - nlat) * 64 + lkey);
    const u16* base = P + (size_t)lrk * S0 + h * 64 + lc * 8;
    kreg = *(const u32x4*)(base + 1024);
    vreg = *(const u32x4*)(base + 2048);
  };
  float knw[8];
#pragma unroll
  for (int j = 0; j < 8; ++j) knw[j] = p.k_norm[lc * 8 + j];
  auto sstore = [&](int buf) {
    {
      float kv[8];
      float ss = 0.f;
#pragma unroll
      for (int j = 0; j < 4; ++j) { kv[2 * j] = lo2f(kreg[j]); kv[2 * j + 1] = hi2f(kreg[j]); }
#pragma unroll
      for (int j = 0; j < 8; ++j) ss += kv[j] * kv[j];
      ss += __shfl_xor(ss, 1); ss += __shfl_xor(ss, 2); ss += __shfl_xor(ss, 4);
      const float rstd = rsqrtf(ss * (1.f / 64.f) + EPSF);
#pragma unroll
      for (int j = 0; j < 4; ++j) kreg[j] = pack2(kv[2 * j] * rstd * knw[2 * j], kv[2 * j + 1] * rstd * knw[2 * j + 1]);
    }
    *(u32x4*)(Ks + buf * 4608 + lkey * 72 + lc * 8) = kreg;
    u16* vt = Vt + buf * 4352 + (lc * 8) * 68 + lkey;
#pragma unroll
    for (int j = 0; j < 4; ++j) {
      vt[(2 * j) * 68] = (u16)(vreg[j] & 0xFFFFu);
      vt[(2 * j + 1) * 68] = (u16)(vreg[j] >> 16);
    }
  };
  gload(0);
  sstore(0);
  __syncthreads();
  for (int i = 0; i < nt; ++i) {
    if (i + 1 < nt) gload(i + 1);
    const int kr = r0a + i;
    const u16* Kb = Ks + (i & 1) * 4608;
    const u16* Vb = Vt + (i & 1) * 4352;
#pragma unroll
    for (int sx = 0; sx < 2; ++sx) {
      const bool active = (i >= nlat) || (kr >= r0s[sx] && kr <= r0s[sx] + 7);
      if (active) {
        f32x4 st[4];
#pragma unroll
        for (int kt = 0; kt < 4; ++kt) {
          st[kt] = zero4();
#pragma unroll
          for (int ks = 0; ks < 2; ++ks) {
            bf16x8 kf = *(const bf16x8*)(Kb + (kt * 16 + fr) * 72 + ks * 32 + fq * 8);
            st[kt] = MFMA16(kf, qf[sx][ks], st[kt]);
          }
        }
        if (i < nlat) {
          const int c0 = min(max(col - 8, 0), 48);
          const float* rb = rpb_s + (kr - rr[sx] + 7) * 31 + 15 - col;
          float bv[4][4];
#pragma unroll
          for (int kt = 0; kt < 4; ++kt)
#pragma unroll
            for (int e = 0; e < 4; ++e) bv[kt][e] = rb[kt * 16 + fq * 4 + e];
#pragma unroll
          for (int kt = 0; kt < 4; ++kt) asm volatile("" : "+v"(bv[kt][0]), "+v"(bv[kt][1]), "+v"(bv[kt][2]), "+v"(bv[kt][3]));
#pragma unroll
          for (int kt = 0; kt < 4; ++kt)
#pragma unroll
            for (int e = 0; e < 4; ++e) {
              const int kc = kt * 16 + fq * 4 + e;
              const bool valid = (kc >= c0) && (kc < c0 + 16);
              st[kt][e] = valid ? (st[kt][e] + bv[kt][e]) : -INFINITY;
            }
        }
        float mx = -INFINITY;
#pragma unroll
        for (int kt = 0; kt < 4; ++kt)
#pragma unroll
          for (int e = 0; e < 4; ++e) mx = fmaxf(mx, st[kt][e]);
        mx = fmaxf(mx, __shfl_xor(mx, 16));
        mx = fmaxf(mx, __shfl_xor(mx, 32));
        const float mnew = fmaxf(mrun[sx], mx);
        const float alpha = __expf(mrun[sx] - mnew);
        mrun[sx] = mnew;
        lrun[sx] *= alpha;
#pragma unroll
        for (int d = 0; d < 4; ++d) ot[sx][d] *= alpha;
        float pe[4][4];
#pragma unroll
        for (int kt = 0; kt < 4; ++kt)
#pragma unroll
          for (int e = 0; e < 4; ++e) { pe[kt][e] = __expf(st[kt][e] - mnew); lrun[sx] += pe[kt][e]; }
#pragma unroll
        for (int kk = 0; kk < 2; ++kk) {
          u32x4 pp;
          pp[0] = pack2(pe[2 * kk][0], pe[2 * kk][1]); pp[1] = pack2(pe[2 * kk][2], pe[2 * kk][3]);
          pp[2] = pack2(pe[2 * kk + 1][0], pe[2 * kk + 1][1]); pp[3] = pack2(pe[2 * kk + 1][2], pe[2 * kk + 1][3]);
          const bf16x8 pf = __builtin_bit_cast(bf16x8, pp);
#pragma unroll
          for (int d = 0; d < 4; ++d) {
            const u16* vrow = Vb + (d * 16 + fr) * 68 + kk * 32 + fq * 4;
            u32x2 lo = *(const u32x2*)vrow, hi = *(const u32x2*)(vrow + 16);
            u32x4 vv; vv[0] = lo[0]; vv[1] = lo[1]; vv[2] = hi[0]; vv[3] = hi[1];
            ot[sx][d] = MFMA16(__builtin_bit_cast(bf16x8, vv), pf, ot[sx][d]);
          }
        }
      }
    }
    if (i + 1 < nt) sstore((i + 1) & 1);
    __syncthreads();
  }
#pragma unroll
  for (int sx = 0; sx < 2; ++sx) {
    float l = lrun[sx];
    l += __shfl_xor(l, 16);
    l += __shfl_xor(l, 32);
    const float inv = rcpf_(l);
#pragma unroll
    for (int d = 0; d < 4; ++d) {
      const int dim = d * 16 + fq * 4;
      u16* qz = P + (size_t)lrq[sx] * S0 + h * 64 + dim;
      u32x2 z = *(const u32x2*)(qz + 3072);
      float y0 = ot[sx][d][0] * inv * siluf_(lo2f(z[0]));
      float y1 = ot[sx][d][1] * inv * siluf_(hi2f(z[0]));
      float y2 = ot[sx][d][2] * inv * siluf_(lo2f(z[1]));
      float y3 = ot[sx][d][3] * inv * siluf_(hi2f(z[1]));
      u32x2 o; o[0] = pack2(y0, y1); o[1] = pack2(y2, y3);
      *(u32x2*)qz = o;
    }
  }
}

static __device__ __forceinline__ void mlstm_unit(const Params& p, int unit) {
  const u16* P = p.P;
  u16* Qs = (u16*)smem;
  u16* Ks = Qs + 64 * 264;
  u16* KT = Ks + 64 * 264;
  u16* VT = KT + 256 * 72;
  u16* CT = VT + 80 * 72;
  u16* Ps = Qs;
  u16* VTW = Ks;
  const int tid = get_tid(), w = tid >> 6, lane = tid & 63, fr = lane & 15, fq = lane >> 4;
  const int vs = unit & 3, dir = (unit >> 2) & 1, h = (unit >> 3) & 3, bl = unit >> 5;
  const int ti = w & 3, g = w >> 2;
  for (int i = tid; i < 80 * 264; i += NT) CT[i] = 0;
  for (int i = tid; i < 16 * 72; i += NT) VT[64 * 72 + i] = (i < 72) ? (u16)0x3F80 : (u16)0;
  f32x4 ct[5][2];
#pragma unroll
  for (int a = 0; a < 5; ++a) { ct[a][0] = zero4(); ct[a][1] = zero4(); }
  float m = 0.f;
  const int dvt[3] = {2 * g, 2 * g + 1, 4};
  const int cq = tid & 15;
  const int kch0 = 2 * lane;
  const int vvp = tid & 31, vgg = (tid >> 5) & 7;
#define MROW_LOW(cc) (((cc) < 4) ? (HL + bl * 256 + (dir ? 192 - (cc) * 64 : (cc) * 64)) : (bl * 4096 + (dir ? 4032 - ((cc) - 4) * 64 : ((cc) - 4) * 64)))
#define PIDX(pp) (dir ? 63 - (pp) : (pp))
  unsigned qoffB[2], koffB[8], voffB[8];
#pragma unroll
  for (int i = 0; i < 2; ++i) qoffB[i] = (unsigned)(PIDX((tid + NT * i) >> 4) * S0 + 4096 + h * 256 + cq * 8) * 2u;
#pragma unroll
  for (int j = 0; j < 8; ++j) {
    koffB[j] = (unsigned)(PIDX(w * 8 + j) * S0 + 5120 + h * 256 + kch0) * 2u;
    voffB[j] = (unsigned)(PIDX(vgg * 8 + j) * S0 + 6144 + h * 256 + vs * 64 + 2 * vvp) * 2u;
  }
  const unsigned goffB = (unsigned)(PIDX(lane) * 16 + 2 * dir * 4 + h) * 4u;
#define MLOAD(rl, QLO, QHI, K1, K2, VV, IG, FG) do { \
    const char* pb_ = (const char*)(P + (size_t)(rl) * S0); const char* gb_ = (const char*)(p.G + (size_t)(rl) * 16); \
    _Pragma("unroll") for (int i = 0; i < 2; ++i) { QLO[i] = *(const u32x4*)(pb_ + qoffB[i]); QHI[i] = *(const u32x4*)(pb_ + qoffB[i] + 256); } \
    _Pragma("unroll") for (int j = 0; j < 8; ++j) { K1[j] = *(const unsigned*)(pb_ + koffB[j]); K2[j] = *(const unsigned*)(pb_ + koffB[j] + 256); } \
    _Pragma("unroll") for (int j = 0; j < 8; ++j) VV[j] = *(const unsigned*)(pb_ + voffB[j]); \
    IG = *(const float*)(gb_ + goffB); FG = *(const float*)(gb_ + goffB + 16); } while (0)
  u32x4 qlo[2], qhi[2];
  unsigned k1[8], k2[8], vv[8];
  float ig, fg;
  { const int rl0 = MROW_LOW(0); MLOAD(rl0, qlo, qhi, k1, k2, vv, ig, fg); }
  __syncthreads();
  for (int c = 0; c < 68; ++c) {
    const int rlow = MROW_LOW(c);
#define rowof(pp) (rlow + PIDX(pp))
    u32x4 qlon[2], qhin[2];
    unsigned k1n[8], k2n[8], vvn[8];
    float ign, fgn;
    { const int cn = (c + 1 < 68) ? c + 1 : c; const int rln = MROW_LOW(cn); MLOAD(rln, qlon, qhin, k1n, k2n, vvn, ign, fgn); }
    const float lf = fminf(fg, 0.f) - fastlogf_(1.f + __expf(-fabsf(fg)));
    const float bcs = wave_scan_add(lf);
    const float av = ig - bcs;
    const float uv = wave_scan_max(av);
    const float Mv = fmaxf(uv, m);
    const float M63 = __shfl(Mv, 63), bL = __shfl(bcs, 63);
    const float wsc = __expf(av - M63);
#pragma unroll
    for (int i = 0; i < 2; ++i) {
      const int pp = (tid + NT * i) >> 4;
      *(u32x4*)(Qs + pp * 264 + cq * 8) = qlo[i];
      *(u32x4*)(Qs + pp * 264 + cq * 8 + 128) = qhi[i];
    }
    {
#pragma unroll
      for (int j = 0; j < 8; ++j) {
        *(unsigned*)(Ks + (w * 8 + j) * 264 + kch0) = k1[j];
        *(unsigned*)(Ks + (w * 8 + j) * 264 + kch0 + 128) = k2[j];
      }
      float ws8[8];
#pragma unroll
      for (int j = 0; j < 8; ++j) ws8[j] = __shfl(wsc, w * 8 + j);
      u32x4 lo, hi;
#pragma unroll
      for (int j = 0; j < 4; ++j) {
        lo[j] = pack2(lo2f(k1[2 * j]) * ws8[2 * j], lo2f(k1[2 * j + 1]) * ws8[2 * j + 1]);
        hi[j] = pack2(hi2f(k1[2 * j]) * ws8[2 * j], hi2f(k1[2 * j + 1]) * ws8[2 * j + 1]);
      }
      *(u32x4*)(KT + (kch0) * 72 + w * 8) = lo;
      *(u32x4*)(KT + (kch0 + 1) * 72 + w * 8) = hi;
#pragma unroll
      for (int j = 0; j < 4; ++j) {
        lo[j] = pack2(lo2f(k2[2 * j]) * ws8[2 * j], lo2f(k2[2 * j + 1]) * ws8[2 * j + 1]);
        hi[j] = pack2(hi2f(k2[2 * j]) * ws8[2 * j], hi2f(k2[2 * j + 1]) * ws8[2 * j + 1]);
      }
      *(u32x4*)(KT + (kch0 + 128) * 72 + w * 8) = lo;
      *(u32x4*)(KT + (kch0 + 129) * 72 + w * 8) = hi;
    }
    if (tid < 256) {
      u32x4 lo, hi;
#pragma unroll
      for (int j = 0; j < 4; ++j) {
        lo[j] = (vv[2 * j] & 0xFFFFu) | (vv[2 * j + 1] << 16);
        hi[j] = (vv[2 * j] >> 16) | (vv[2 * j + 1] & 0xFFFF0000u);
      }
      *(u32x4*)(VT + (2 * vvp) * 72 + vgg * 8) = lo;
      *(u32x4*)(VT + (2 * vvp + 1) * 72 + vgg * 8) = hi;
    }
    __syncthreads();
    f32x4 acc3[3], s2[2];
#pragma unroll
    for (int j = 0; j < 3; ++j) acc3[j] = zero4();
    s2[0] = zero4(); s2[1] = zero4();
#pragma unroll 4
    for (int ks = 0; ks < 8; ++ks) {
      const bf16x8 qf = *(const bf16x8*)(Qs + (ti * 16 + fr) * 264 + ks * 32 + fq * 8);
#pragma unroll
      for (int j = 0; j < 3; ++j) {
        const bf16x8 cf = *(const bf16x8*)(CT + (dvt[j] * 16 + fr) * 264 + ks * 32 + fq * 8);
        acc3[j] = MFMA16(cf, qf, acc3[j]);
      }
#pragma unroll
      for (int jj = 0; jj < 2; ++jj) {
        if (2 * g + jj <= ti) {
          const bf16x8 kf = *(const bf16x8*)(Ks + ((2 * g + jj) * 16 + fr) * 264 + ks * 32 + fq * 8);
          s2[jj] = MFMA16(kf, qf, s2[jj]);
        }
      }
    }
    const int tq = ti * 16 + fr;
    const float Mt = __shfl(Mv, tq);
    const float cw = __expf(m - Mt);
    const float bt = __shfl(bcs, tq);
    __syncthreads();
#pragma unroll
    for (int jj = 0; jj < 2; ++jj) {
      const int s0 = (2 * g + jj) * 16 + fq * 4;
      float pv[4];
#pragma unroll
      for (int e = 0; e < 4; ++e) {
        const float as = __shfl(av, s0 + e);
        const float D = (s0 + e <= tq) ? __expf(as - Mt) : 0.f;
        pv[e] = s2[jj][e] * D;
      }
      u32x2 o; o[0] = pack2(pv[0], pv[1]); o[1] = pack2(pv[2], pv[3]);
      *(u32x2*)(Ps + tq * 72 + s0) = o;
    }
    __syncthreads();
#pragma unroll
    for (int j = 0; j < 3; ++j) acc3[j] *= cw;
#pragma unroll
    for (int ks = 0; ks < 2; ++ks) {
      const bf16x8 pf = *(const bf16x8*)(Ps + (ti * 16 + fr) * 72 + ks * 32 + fq * 8);
#pragma unroll
      for (int j = 0; j < 3; ++j) {
        const bf16x8 vf = *(const bf16x8*)(VT + (dvt[j] * 16 + fr) * 72 + ks * 32 + fq * 8);
        acc3[j] = MFMA16(vf, pf, acc3[j]);
      }
    }
    {
      const float den = __shfl(acc3[2][0], fr);
      const float inv = rcpf_(fmaxf(fabsf(den), __expf(-(bt + Mt))));
      u16* dst = p.HD + ((size_t)dir * HR + rowof(tq)) * 1024 + h * 256 + vs * 64 + fq * 4;
#pragma unroll
      for (int j = 0; j < 2; ++j) {
        u32x2 o; o[0] = pack2(acc3[j][0] * inv, acc3[j][1] * inv); o[1] = pack2(acc3[j][2] * inv, acc3[j][3] * inv);
        *(u32x2*)(dst + dvt[j] * 16) = o;
      }
    }
    {
      const float dec = __expf(m - M63);
#pragma unroll
      for (int a = 0; a < 5; ++a) { ct[a][0] *= dec; ct[a][1] *= dec; }
#pragma unroll
      for (int ks = 0; ks < 2; ++ks) {
        bf16x8 bk[2];
#pragma unroll
        for (int kk = 0; kk < 2; ++kk) bk[kk] = *(const bf16x8*)(KT + ((2 * w + kk) * 16 + fr) * 72 + ks * 32 + fq * 8);
#pragma unroll
        for (int a = 0; a < 5; ++a) {
          const bf16x8 vf = *(const bf16x8*)(VT + (a * 16 + fr) * 72 + ks * 32 + fq * 8);
          ct[a][0] = MFMA16(bk[0], vf, ct[a][0]);
          ct[a][1] = MFMA16(bk[1], vf, ct[a][1]);
        }
      }
#pragma unroll
      for (int a = 0; a < 5; ++a)
#pragma unroll
        for (int kk = 0; kk < 2; ++kk) {
          u32x2 o; o[0] = pack2(ct[a][kk][0], ct[a][kk][1]); o[1] = pack2(ct[a][kk][2], ct[a][kk][3]);
          *(u32x2*)(CT + (a * 16 + fr) * 264 + (2 * w + kk) * 16 + fq * 4) = o;
        }
    }
    m = bL + M63;
#pragma unroll
    for (int i = 0; i < 2; ++i) { qlo[i] = qlon[i]; qhi[i] = qhin[i]; }
#pragma unroll
    for (int j = 0; j < 8; ++j) { k1[j] = k1n[j]; k2[j] = k2n[j]; vv[j] = vvn[j]; }
    ig = ign; fg = fgn;
    __syncthreads();
  }
}

static __device__ __forceinline__ void mlstm_merge_phase(const Params& p) {
  const int tid = get_tid(), w = tid >> 6, lane = tid & 63;
  for (int lr = blockIdx.x * 8 + w; lr < HR; lr += gridDim.x * 8) {
#pragma unroll
    for (int pass = 0; pass < 2; ++pass) {
      const int c = pass * 512 + lane * 8;
      u32x4 hf = *(const u32x4*)(p.HD + (size_t)lr * 1024 + c);
      u32x4 hbk = *(const u32x4*)(p.HD + ((size_t)HR + lr) * 1024 + c);
      u16* pz = p.P + (size_t)lr * S0 + 8192 + c;
      u32x4 ob = *(const u32x4*)(pz - 1024);
      u32x4 zb = *(const u32x4*)pz;
      float v[8];
      float ss = 0.f;
#pragma unroll
      for (int j = 0; j < 4; ++j) {
        v[2 * j] = (lo2f(hf[j]) + lo2f(hbk[j])) * sigmoidf_(lo2f(ob[j]));
        v[2 * j + 1] = (hi2f(hf[j]) + hi2f(hbk[j])) * sigmoidf_(hi2f(ob[j]));
        ss += v[2 * j] * v[2 * j] + v[2 * j + 1] * v[2 * j + 1];
      }
#pragma unroll
      for (int o = 1; o <= 16; o <<= 1) ss += __shfl_xor(ss, o);
      const float rstd = rsqrtf(ss * (1.f / 256.f) + EPSF);
      const float* hn = p.h_norm_b + c;
      u32x4 o;
#pragma unroll
      for (int j = 0; j < 4; ++j) {
        float y0 = v[2 * j] * rstd * hn[2 * j] * siluf_(lo2f(zb[j]));
        float y1 = v[2 * j + 1] * rstd * hn[2 * j + 1] * siluf_(hi2f(zb[j]));
        o[j] = pack2(y0, y1);
      }
      *(u32x4*)(p.P + (size_t)lr * S0 + 1024 + c) = o;
    }
  }
}

#undef rowof
#define rowof(pp) (rbase + rsgn * (pp))
static __device__ __forceinline__ void gla_unit(const Params& p, int unit) {
  u16* P = p.P;
  u16* Qt = (u16*)smem;
  u16* Kt = Qt + 64 * 136;
  u16* KHT = Kt + 64 * 136;
  u16* VT = KHT + 128 * 72;
  u16* Ps = VT + 128 * 72;
  u16* ST = Ps + 64 * 72;
  float* tot = (float*)(ST + 128 * 136);
  float* sbL = tot + 1024;
  const int tid = get_tid(), w = tid >> 6, lane = tid & 63, fr = lane & 15, fq = lane >> 4;
  const int seg = unit >> 7, ub = unit & 127;
  const int dir = ub & 1, h = (ub >> 1) & 15, bl = ub >> 5;
  const int c0 = seg ? 36 : 0, c1 = seg ? 68 : 36;
  const int ti = w & 3, g2 = w >> 2;
  u16* QC = p.HD + (size_t)ub * 2048 * 128;
  float eruna = 1.f, erunb = 1.f;
  for (int i = tid; i < 128 * 136; i += NT) ST[i] = 0;
  f32x4 st[8];
#pragma unroll
  for (int a = 0; a < 8; ++a) st[a] = zero4();
  const int lfcol = 2048 + dir * 2048 + h * 128;
#define GROW_LOW(cc) (((cc) < 4) ? (HL + bl * 256 + (dir ? 192 - (cc) * 64 : (cc) * 64)) : (bl * 4096 + (dir ? 4032 - ((cc) - 4) * 64 : ((cc) - 4) * 64)))
#undef rowof
#define rowof(pp) (rlow + (dir ? 63 - (pp) : (pp)))
  unsigned toffB[8];
#pragma unroll
  for (int j = 0; j < 8; ++j) toffB[j] = (unsigned)((dir ? 63 - (w * 8 + j) : (w * 8 + j)) * S1 + 2 * lane) * 2u;
#define GLOAD(rl, Q2, L2, V2, WITHQ) do { \
    const char* pq_ = (const char*)(P + (size_t)(rl) * S1 + h * 128); const char* pl_ = (const char*)(P + (size_t)(rl) * S1 + lfcol); \
    const char* pv_ = (const char*)(P + (size_t)(rl) * S1 + 6144 + h * 128); \
    _Pragma("unroll") for (int j = 0; j < 8; ++j) { Q2[j] = (WITHQ) ? *(const unsigned*)(pq_ + toffB[j]) : 0u; \
      L2[j] = *(const unsigned*)(pl_ + toffB[j]); V2[j] = *(const unsigned*)(pv_ + toffB[j]); } } while (0)
  unsigned qE[8], lE[8], vE[8], qO[8], lO[8], vO[8];
  { const int rl0 = GROW_LOW(c0); GLOAD(rl0, qE, lE, vE, seg != 0); const int rl1 = GROW_LOW(c0 + 1); GLOAD(rl1, qO, lO, vO, (c0 + 1) >= 4); }
  __syncthreads();
  auto chunk_body = [&](const int c, unsigned (&q2)[8], unsigned (&l2)[8], unsigned (&v2)[8]) {
    const bool lat = c >= 4;
    const int rlow = GROW_LOW(c);
    float fa[8], fb[8], ca[8], cb[8];
    {
      float ra = 1.f, rb = 1.f;
#pragma unroll
      for (int j = 0; j < 8; ++j) { fa[j] = __expf(lo2f(l2[j])); fb[j] = __expf(hi2f(l2[j])); ra *= fa[j]; rb *= fb[j]; ca[j] = ra; cb[j] = rb; }
      tot[w * 128 + 2 * lane] = ra;
      tot[w * 128 + 2 * lane + 1] = rb;
    }
    __syncthreads();
    float offa = 1.f, offb = 1.f, ELa = 1.f, ELb = 1.f;
#pragma unroll
    for (int g = 0; g < 8; ++g) {
      const float ta = tot[g * 128 + 2 * lane], tb = tot[g * 128 + 2 * lane + 1];
      if (g < w) { offa *= ta; offb *= tb; }
      ELa *= ta; ELb *= tb;
    }
    {
      u32x4 kha, khb, va, vb;
      unsigned kh2[8];
#pragma unroll
      for (int j = 0; j < 8; ++j) {
        const float ea = fmaxf(offa * ca[j], 1e-30f), eb = fmaxf(offb * cb[j], 1e-30f);
        const float ia = __builtin_amdgcn_rcpf(ea), ib = __builtin_amdgcn_rcpf(eb);
        const float kta = (1.f - fa[j]) * ia, ktb = (1.f - fb[j]) * ib;
        const int pp = w * 8 + j;
        const float qa = lo2f(q2[j]) * ea, qb = hi2f(q2[j]) * eb;
        *(unsigned*)(Qt + pp * 136 + 2 * lane) = pack2(qa, qb);
        if (seg) *(unsigned*)(QC + (size_t)((c - 36) * 64 + pp) * 128 + 2 * lane) = pack2(qa * eruna, qb * erunb);
        *(unsigned*)(Kt + pp * 136 + 2 * lane) = pack2(kta, ktb);
        kh2[j] = pack2(kta * ELa, ktb * ELb);
      }
#pragma unroll
      for (int j = 0; j < 4; ++j) {
        kha[j] = (kh2[2 * j] & 0xFFFFu) | (kh2[2 * j + 1] << 16);
        khb[j] = (kh2[2 * j] >> 16) | (kh2[2 * j + 1] & 0xFFFF0000u);
        va[j] = (v2[2 * j] & 0xFFFFu) | (v2[2 * j + 1] << 16);
        vb[j] = (v2[2 * j] >> 16) | (v2[2 * j + 1] & 0xFFFF0000u);
      }
      *(u32x4*)(KHT + (2 * lane) * 72 + w * 8) = kha;
      *(u32x4*)(KHT + (2 * lane + 1) * 72 + w * 8) = khb;
      *(u32x4*)(VT + (2 * lane) * 72 + w * 8) = va;
      *(u32x4*)(VT + (2 * lane + 1) * 72 + w * 8) = vb;
      if (w == 0) { sbL[2 * lane] = ELa; sbL[2 * lane + 1] = ELb; }
      eruna *= ELa; erunb *= ELb;
    }
    if (c + 2 < c1) { const int rl2 = GROW_LOW(c + 2); GLOAD(rl2, q2, l2, v2, (c + 2) >= 4); }
    __syncthreads();
    f32x4 o4[4];
#pragma unroll
    for (int j = 0; j < 4; ++j) o4[j] = zero4();
    const int tq = ti * 16 + fr;
    if (lat) {
      f32x4 s2[2];
      s2[0] = zero4(); s2[1] = zero4();
#pragma unroll
      for (int ks = 0; ks < 4; ++ks) {
        const bf16x8 qf = *(const bf16x8*)(Qt + (ti * 16 + fr) * 136 + ks * 32 + fq * 8);
#pragma unroll
        for (int j = 0; j < 4; ++j) {
          const bf16x8 sf = *(const bf16x8*)(ST + ((4 * g2 + j) * 16 + fr) * 136 + ks * 32 + fq * 8);
          o4[j] = MFMA16(sf, qf, o4[j]);
        }
#pragma unroll
        for (int jj = 0; jj < 2; ++jj) {
          if (2 * g2 + jj <= ti) {
            const bf16x8 kf = *(const bf16x8*)(Kt + ((2 * g2 + jj) * 16 + fr) * 136 + ks * 32 + fq * 8);
            s2[jj] = MFMA16(kf, qf, s2[jj]);
          }
        }
      }
#pragma unroll
      for (int jj = 0; jj < 2; ++jj) {
        const int s0 = (2 * g2 + jj) * 16 + fq * 4;
        u32x2 o;
        o[0] = pack2((s0 + 0 <= tq) ? s2[jj][0] : 0.f, (s0 + 1 <= tq) ? s2[jj][1] : 0.f);
        o[1] = pack2((s0 + 2 <= tq) ? s2[jj][2] : 0.f, (s0 + 3 <= tq) ? s2[jj][3] : 0.f);
        *(u32x2*)(Ps + tq * 72 + s0) = o;
      }
    }
    __syncthreads();
    if (lat) {
#pragma unroll
      for (int ks = 0; ks < 2; ++ks) {
        const bf16x8 pf = *(const bf16x8*)(Ps + (ti * 16 + fr) * 72 + ks * 32 + fq * 8);
#pragma unroll
        for (int j = 0; j < 4; ++j) {
          const bf16x8 vf = *(const bf16x8*)(VT + ((4 * g2 + j) * 16 + fr) * 72 + ks * 32 + fq * 8);
          o4[j] = MFMA16(vf, pf, o4[j]);
        }
      }
      u16* dst = P + (size_t)rowof(tq) * S1 + lfcol + (4 * g2) * 16 + fq * 4;
#pragma unroll
      for (int j = 0; j < 4; ++j) {
        u32x2 o; o[0] = pack2(o4[j][0], o4[j][1]); o[1] = pack2(o4[j][2], o4[j][3]);
        *(u32x2*)(dst + j * 16) = o;
      }
    }
    {
      const f32x4 dk = *(const f32x4*)(sbL + 16 * w + fq * 4);
#pragma unroll
      for (int a = 0; a < 8; ++a) st[a] *= dk;
#pragma unroll
      for (int ks = 0; ks < 2; ++ks) {
        const bf16x8 kf = *(const bf16x8*)(KHT + (w * 16 + fr) * 72 + ks * 32 + fq * 8);
#pragma unroll
        for (int a = 0; a < 8; ++a) {
          const bf16x8 vf = *(const bf16x8*)(VT + (a * 16 + fr) * 72 + ks * 32 + fq * 8);
          st[a] = MFMA16(kf, vf, st[a]);
        }
      }
#pragma unroll
      for (int a = 0; a < 8; ++a) {
        u32x2 o; o[0] = pack2(st[a][0], st[a][1]); o[1] = pack2(st[a][2], st[a][3]);
        *(u32x2*)(ST + (a * 16 + fr) * 136 + 16 * w + fq * 4) = o;
      }
    }
    __syncthreads();
  };
  for (int c = c0; c < c1; c += 2) { chunk_body(c, qE, lE, vE); chunk_body(c + 1, qO, lO, vO); }
  if (!seg) {
    u16* SM = p.H + (size_t)ub * 128 * 128;
    for (int i = tid; i < 128 * 16; i += NT) { const int r = i >> 4, c8 = (i & 15) * 8; *(u32x4*)(SM + r * 128 + c8) = *(const u32x4*)(ST + r * 136 + c8); }
  }
}

static __device__ __forceinline__ void gla_corr_phase(const Params& p) {
  u16* P = p.P;
  u16* SMs = (u16*)smem;
  u16* Qs = SMs + 128 * 136;
  const int tid = get_tid(), w = tid >> 6, lane = tid & 63, fr = lane & 15, fq = lane >> 4;
  const int ti = w & 3, g2 = w >> 2;
  for (int item = get_bid(); item < 256; item += gridDim.x) {
    const int ub = item >> 1, half = item & 1;
    const int dir = ub & 1, h = (ub >> 1) & 15, bl = ub >> 5;
    const int lfcol = 2048 + dir * 2048 + h * 128;
    const u16* SM = p.H + (size_t)ub * 128 * 128;
    const u16* QC = p.HD + (size_t)ub * 2048 * 128;
    __syncthreads();
    for (int i = tid; i < 128 * 16; i += NT) { const int r = i >> 4, c8 = (i & 15) * 8; *(u32x4*)(SMs + r * 136 + c8) = *(const u32x4*)(SM + r * 128 + c8); }
    for (int cc = half * 16; cc < half * 16 + 16; ++cc) {
      __syncthreads();
      for (int i = tid; i < 64 * 16; i += NT) { const int r = i >> 4, c8 = (i & 15) * 8; *(u32x4*)(Qs + r * 136 + c8) = *(const u32x4*)(QC + (size_t)(cc * 64 + r) * 128 + c8); }
      __syncthreads();
      f32x4 o4[4];
#pragma unroll
      for (int j = 0; j < 4; ++j) o4[j] = zero4();
#pragma unroll
      for (int ks = 0; ks < 4; ++ks) {
        const bf16x8 qf = *(const bf16x8*)(Qs + (ti * 16 + fr) * 136 + ks * 32 + fq * 8);
#pragma unroll
        for (int j = 0; j < 4; ++j) {
          const bf16x8 sf = *(const bf16x8*)(SMs + ((4 * g2 + j) * 16 + fr) * 136 + ks * 32 + fq * 8);
          o4[j] = MFMA16(sf, qf, o4[j]);
        }
      }
      const int tq = ti * 16 + fr;
      const int rlow = bl * 4096 + (dir ? 4032 - (32 + cc) * 64 : (32 + cc) * 64);
      const int row = rlow + (dir ? 63 - tq : tq);
      u16* dst = P + (size_t)row * S1 + lfcol + (4 * g2) * 16 + fq * 4;
#pragma unroll
      for (int j = 0; j < 4; ++j) {
        u32x2 v = *(const u32x2*)(dst + j * 16);
        u32x2 o; o[0] = pack2(lo2f(v[0]) + o4[j][0], hi2f(v[0]) + o4[j][1]); o[1] = pack2(lo2f(v[1]) + o4[j][2], hi2f(v[1]) + o4[j][3]);
        *(u32x2*)(dst + j * 16) = o;
      }
    }
  }
}

static __device__ __forceinline__ void gla_merge_phase(const Params& p) {
  const int tid = get_tid(), w = tid >> 6, lane = tid & 63;
  for (int lr = blockIdx.x * 8 + w; lr < HL; lr += gridDim.x * 8) {
#pragma unroll
    for (int pass = 0; pass < 4; ++pass) {
      const int c = pass * 512 + lane * 8;
      u16* pz = p.P + (size_t)lr * S1 + 8192 + c;
      u32x4 of = *(const u32x4*)(pz - 6144);
      u32x4 ob = *(const u32x4*)(pz - 4096);
      u32x4 zb = *(const u32x4*)pz;
      float v[8];
      float ss = 0.f;
#pragma unroll
      for (int j = 0; j < 4; ++j) {
        v[2 * j] = lo2f(of[j]) + lo2f(ob[j]);
        v[2 * j + 1] = hi2f(of[j]) + hi2f(ob[j]);
        ss += v[2 * j] * v[2 * j] + v[2 * j + 1] * v[2 * j + 1];
      }
#pragma unroll
      for (int o = 1; o <= 8; o <<= 1) ss += __shfl_xor(ss, o);
      const float rstd = rsqrtf(ss * (1.f / 128.f) + EPSF);
      const float* hn = p.h_norm_c + c;
      u32x4 o;
#pragma unroll
      for (int j = 0; j < 4; ++j) {
        float y0 = v[2 * j] * rstd * hn[2 * j] * siluf_(lo2f(zb[j]));
        float y1 = v[2 * j + 1] * rstd * hn[2 * j + 1] * siluf_(hi2f(zb[j]));
        o[j] = pack2(y0, y1);
      }
      *(u32x4*)pz = o;
    }
  }
}

#define XB_TMO      128
#define XB_XCNT(j)  (256  + 64 * (j))
#define XB_XSUB(j)  (1280 + 64 * (j))
#define XB_XGEN(j)  (2304 + 64 * (j))
#define XB_TOP      3328
#define XB_TOPGEN   3392
#define XCD_BAR_WORDS 3456
#define XB_SPIN_CAP (1u << 18)
DI unsigned xb_ld(unsigned* p) { return __hip_atomic_load(p, __ATOMIC_RELAXED, __HIP_MEMORY_SCOPE_AGENT); }
DI unsigned xb_add(unsigned* p, unsigned v) { return __hip_atomic_fetch_add(p, v, __ATOMIC_RELAXED, __HIP_MEMORY_SCOPE_AGENT); }
DI unsigned xb_xcc_id() { return (unsigned)__builtin_amdgcn_s_getreg((3 << 11) | 20) & 0xFu; }
#define XB_SPIN(cond, bar) do { unsigned _sp = 0; while (cond) { __builtin_amdgcn_s_sleep(1); \
    if ((++_sp & 255u) == 0u) { if (xb_ld(&(bar)[XB_TMO])) break; if (_sp > XB_SPIN_CAP) { atomicAdd(&(bar)[XB_TMO], 1u); break; } } } } while (0)
struct XcdBarrier { unsigned* bar; unsigned x; volatile LAS unsigned* st; };
DI XcdBarrier xcd_barrier_post(unsigned* bar, volatile LAS unsigned* st) {
  XcdBarrier b; b.bar = bar; b.x = xb_xcc_id(); b.st = st;
  if (threadIdx.x == 0) (void)xb_add(&bar[XB_XCNT(b.x)], 1u);
  return b;
}
DI void xcd_barrier_complete(unsigned* bar, unsigned x, unsigned& nloc, unsigned& nx) {
  const unsigned G = gridDim.x * gridDim.y * gridDim.z;
  unsigned sum, cnt, mine, sp = 0u;
  for (;;) {
    sum = 0u; cnt = 0u; mine = 0u;
#pragma unroll
    for (unsigned j = 0; j < 16; ++j) { const unsigned c = xb_ld(&bar[XB_XCNT(j)]); sum += c; cnt += (c > 0u) ? 1u : 0u; mine = (j == x) ? c : mine; }
    if (sum == G) break;
    __builtin_amdgcn_s_sleep(1);
    if ((++sp & 255u) == 0u) { if (xb_ld(&bar[XB_TMO])) break; if (sp > XB_SPIN_CAP) { atomicAdd(&bar[XB_TMO], 1u); break; } }
  }
  nloc = mine > 0u ? mine : 1u; nx = cnt > 0u ? cnt : 1u;
}
DI void xcd_barrier(const XcdBarrier& b) {
  asm volatile("s_waitcnt vmcnt(0)" ::: "memory");
  __syncthreads();
  if (threadIdx.x == 0) {
    unsigned* bar = b.bar;
    __builtin_amdgcn_s_waitcnt(0);
    unsigned nloc = b.st[0], nx = b.st[1];
    if (nloc == 0u) { xcd_barrier_complete(bar, b.x, nloc, nx); b.st[0] = nloc; b.st[1] = nx; }
    const unsigned old = xb_add(&bar[XB_XSUB(b.x)], 1u);
    const unsigned gen = old / nloc;
    if (old + 1u == (gen + 1u) * nloc) {
      __builtin_amdgcn_fence(__ATOMIC_RELEASE, "agent");
      asm volatile("s_waitcnt vmcnt(0)" ::: "memory");
      const unsigned og = xb_add(&bar[XB_TOP], 1u);
      const unsigned tg = og / nx;
      if (og + 1u == (tg + 1u) * nx) xb_add(&bar[XB_TOPGEN], 1u);
      else XB_SPIN(xb_ld(&bar[XB_TOPGEN]) == tg, bar);
      __builtin_amdgcn_fence(__ATOMIC_ACQUIRE, "agent");
      xb_add(&bar[XB_XGEN(b.x)], 1u);
      asm volatile("s_waitcnt vmcnt(0)" ::: "memory");
    } else {
      XB_SPIN(xb_ld(&bar[XB_XGEN(b.x)]) == gen, bar);
      __builtin_amdgcn_fence(__ATOMIC_ACQUIRE, "agent");
      asm volatile("s_waitcnt vmcnt(0)" ::: "memory");
    }
  }
  __syncthreads();
}

__global__ void __launch_bounds__(512) fwd_megakernel(Params p) {
  cg::grid_group grid = cg::this_grid();
  volatile LAS unsigned* xst = (volatile LAS unsigned*)((LAS unsigned char*)smem + LDS_ST_OFF);
  if (threadIdx.x == 0) { xst[0] = 0u; xst[1] = 0u; xst[2] = 0u; xst[3] = 0u; }
  __syncthreads();
  const XcdBarrier xb = xcd_barrier_post(p.bar, xst);
  prep_phase(p);
  grid.sync();
  for (int hb = 0; hb < 2; ++hb) {
    rmsmod_phase(p, 0, hb);
    xcd_barrier(xb);
    { GemmArgs g{p.H, 1024, p.wt1, 1024, 68, 37}; Epi1 e{p.P, p.G, p.b_gate}; gemm_phase(g, e); }
    xcd_barrier(xb);
    if (blockIdx.x < 128) mlstm_unit(p, blockIdx.x);
    for (;;) {
      __syncthreads();
      if (threadIdx.x == 0) xst[4] = xb_add(&p.bar[3500 + hb], 1u);
      __syncthreads();
      const unsigned u = xst[4];
      if (u >= (unsigned)NA_UNITS) break;
      na_unit(p, (int)u);
    }
    xcd_barrier(xb);
    mlstm_merge_phase(p);
    xcd_barrier(xb);
    { GemmArgs g{p.P, S0, p.wt2, 2048, 68, 4}; EpiRes e{p.x, p.ctx, p.out, p.x1c, p.ada, hb, 0}; gemm_phase(g, e); }
  }
  for (int hb = 0; hb < 2; ++hb) {
    rmsmod_phase(p, 1, hb);
    xcd_barrier(xb);
    { GemmArgs g{p.H, 1024, p.wt3, 1024, 68, 40}; Epi3 e{p.P, p.lb_c}; gemm_phase(g, e); }
    xcd_barrier(xb);
    if (blockIdx.x < 256) gla_unit(p, blockIdx.x);
    xcd_barrier(xb);
    gla_corr_phase(p);
    xcd_barrier(xb);
    gla_merge_phase(p);
    xcd_barrier(xb);
    { GemmArgs g{p.P + 8192, S1, p.wt4, 2048, 64, 4}; EpiRes e{p.x, p.ctx, p.out, p.x1c, p.ada, hb, 1}; gemm_phase(g, e); }
  }
}

extern "C" void kernel_launch(void* const* d_in, const int* in_sizes, int n_in, void* d_out, int out_size,
                              void* d_ws, size_t ws_size, hipStream_t stream) {
  static int grid_blocks = 0;
  if (!grid_blocks) {
    int dev = 0, cus = 0, per_cu = 0;
    (void)hipGetDevice(&dev);
    (void)hipDeviceGetAttribute(&cus, hipDeviceAttributeMultiprocessorCount, dev);
    (void)hipFuncSetAttribute((const void*)fwd_megakernel, hipFuncAttributeMaxDynamicSharedMemorySize, LDS_BYTES);
    (void)hipOccupancyMaxActiveBlocksPerMultiprocessor(&per_cu, (const void*)fwd_megakernel, NT, LDS_BYTES);
    if (per_cu < 1) per_cu = 1;
    grid_blocks = cus * per_cu;
    if (ws_size < WS_END) { fprintf(stderr, "workspace too small: %zu < %zu\n", ws_size, (size_t)WS_END); grid_blocks = -1; }
    if (grid_blocks < 256) { fprintf(stderr, "grid %d < 256 not supported\n", grid_blocks); grid_blocks = -1; }
  }
  if (grid_blocks < 0) return;
  Params p{};
  p.x = (const float*)d_in[0]; p.c = (const float*)d_in[1]; p.ctx = (const float*)d_in[2]; p.c_ctx = (const float*)d_in[3];
  p.norm_w = (const float*)d_in[4]; p.w_ada = (const float*)d_in[5]; p.b_ada = (const float*)d_in[6];
  p.w_in_ab = (const float*)d_in[7]; p.b_gate = (const float*)d_in[8]; p.q_norm = (const float*)d_in[9];
  p.k_norm = (const float*)d_in[10]; p.rpb = (const float*)d_in[11]; p.h_norm_b = (const float*)d_in[12];
  p.w_out_ab = (const float*)d_in[13]; p.w_in_c = (const float*)d_in[14]; p.lb_c = (const float*)d_in[15];
  p.h_norm_c = (const float*)d_in[16]; p.w_out_c = (const float*)d_in[17];
  p.out = (float*)d_out;
  unsigned char* ws = (unsigned char*)d_ws;
  p.wt1 = (u16*)(ws + OFF_WT1); p.wt2 = (u16*)(ws + OFF_WT2); p.wt3 = (u16*)(ws + OFF_WT3); p.wt4 = (u16*)(ws + OFF_WT4);
  p.ada = (float*)(ws + OFF_ADA); p.x1c = (float*)(ws + OFF_X1C); p.G = (float*)(ws + OFF_G);
  p.H = (u16*)(ws + OFF_H); p.HD = (u16*)(ws + OFF_HD); p.P = (u16*)(ws + OFF_P);
  p.bar = (unsigned*)(ws + OFF_BAR);
  (void)hipMemsetAsync(ws + OFF_BAR, 0, 16384, stream);
  void* args[] = {&p};
  hipError_t e = hipLaunchCooperativeKernel((void*)fwd_megakernel, dim3(grid_blocks), dim3(NT), args, LDS_BYTES, stream);
  if (e != hipSuccess) fprintf(stderr, "cooperative launch failed: %s (grid %d)\n", hipGetErrorString(e), grid_blocks);
}
```
